# Optimizing an MI355X kernel written in HIP

```python
import jax, jax.numpy as jnp
from jax import lax
import numpy as np

D_MODEL = 1024
BATCH = 8
SEQ = 2048
DEPTH = 1

EPS = 1e-6
A_HEADS = 16
A_QK_DIM = 64
A_V_DIM = 64
A_Q_RANK = 256
A_KV_RANK = 256
IDX_HEADS = 8
IDX_DIM = 64
TOPK_MAX = 256
Q_BLOCK = 128
A_WIDTH = A_HEADS * A_V_DIM
B_HEADS = 8
B_K_DIM = 128
B_V_DIM = 128
B_QK = B_HEADS * B_K_DIM
B_VW = B_HEADS * B_V_DIM
CONV_WIDTH = 4
CHUNK = 64
D_FF = ((8 * D_MODEL // 3 + 255) // 256) * 256
IN_SIZES = (A_Q_RANK, A_KV_RANK, IDX_DIM, IDX_HEADS,
            B_QK, B_QK, B_VW, B_HEADS, B_HEADS, B_VW,
            D_MODEL, D_MODEL)
IN_WIDTH = (A_Q_RANK + A_KV_RANK + IDX_DIM + IDX_HEADS
            + 2 * B_QK + 2 * B_VW + 2 * B_HEADS + 2 * D_MODEL)

kernel_name = "hybrid_dsa_gdn_gated_merge"


def rmsnorm(x, g):
    xf = x.astype(jnp.float32)
    y = xf * lax.rsqrt(jnp.mean(xf * xf, axis=-1, keepdims=True) + EPS)
    return (y * g.astype(jnp.float32)).astype(x.dtype)


def layernorm(x, g, b):
    xf = x.astype(jnp.float32)
    mu = jnp.mean(xf, axis=-1, keepdims=True)
    xc = xf - mu
    y = xc * lax.rsqrt(jnp.mean(xc * xc, axis=-1, keepdims=True) + EPS)
    return (y * g.astype(jnp.float32) + b.astype(jnp.float32)).astype(x.dtype)


def l2norm(x):
    xf = x.astype(jnp.float32)
    return xf * lax.rsqrt(jnp.sum(xf * xf, axis=-1, keepdims=True) + EPS)


def dsa_attention(c_q, c_kv, k_idx_raw, w_idx_raw, cq_g, ckv_g, w_uq, w_uk, w_uv,
                  w_iq, kln_g, kln_b):
    B, L, _ = c_q.shape
    topk = min(TOPK_MAX, L // 4)
    nb = L // Q_BLOCK
    cq = rmsnorm(c_q, cq_g)
    ckv = rmsnorm(c_kv, ckv_g)
    q = (cq @ w_uq).reshape(B, L, A_HEADS, A_QK_DIM)
    q_lat = jnp.einsum('blhd,hdr->blhr', q, w_uk)
    q_idx = (cq @ w_iq).reshape(B, L, IDX_HEADS, IDX_DIM)
    k_idx = layernorm(k_idx_raw, kln_g, kln_b).astype(jnp.float32)
    w_idx = w_idx_raw * (IDX_HEADS ** -0.5 * IDX_DIM ** -0.5)
    key_pos = jnp.arange(L)

    def to_blocks(t):
        return t.reshape(B, nb, Q_BLOCK, *t.shape[2:]).swapaxes(0, 1)

    def block(args):
        i, ql, qi, wi = args
        q_pos = i * Q_BLOCK + jnp.arange(Q_BLOCK)
        causal = key_pos[None, :] <= q_pos[:, None]
        logits = jnp.einsum('bqhd,bsd->bqhs', qi.astype(jnp.float32), k_idx)
        score = jnp.einsum('bqh,bqhs->bqs', wi.astype(jnp.float32), jax.nn.relu(logits))
        score = jnp.where(causal[None], score, -jnp.inf)
        _, sel = lax.top_k(score, topk)
        valid = sel <= q_pos[None, :, None]
        kv_sel = jax.vmap(lambda kv, ix: kv[ix])(ckv, sel)
        s = jnp.einsum('bqhr,bqkr->bqhk', ql, kv_sel).astype(jnp.float32) * (A_QK_DIM ** -0.5)
        s = jnp.where(valid[:, :, None, :], s, -jnp.inf)
        p = jax.nn.softmax(s, axis=-1).astype(ckv.dtype)
        return jnp.einsum('bqhk,bqkr->bqhr', p, kv_sel)

    o_lat = lax.map(block, (jnp.arange(nb), to_blocks(q_lat), to_blocks(q_idx), to_blocks(w_idx)))
    o_lat = o_lat.swapaxes(0, 1).reshape(B, L, A_HEADS, A_KV_RANK)
    o = jnp.einsum('blhr,hrd->blhd', o_lat, w_uv)
    return o.reshape(B, L, A_WIDTH)


def short_conv(x, w):
    C = x.shape[-1]
    return lax.conv_general_dilated(
        x, w[:, None, :].astype(x.dtype), window_strides=(1,),
        padding=[(CONV_WIDTH - 1, 0)], dimension_numbers=('NWC', 'WIO', 'NWC'),
        feature_group_count=C)


def gated_delta_rule(q, k, v, g, beta):
    B, L, H, Dk = q.shape
    Dv = v.shape[-1]
    N = L // CHUNK
    def ch4(t):
        return t.reshape(B, N, CHUNK, H, t.shape[-1]).transpose(1, 0, 3, 2, 4)
    def ch3(t):
        return t.reshape(B, N, CHUNK, H).transpose(1, 0, 3, 2)
    qc = ch4(q * (Dk ** -0.5))
    kc, vc = ch4(k), ch4(v)
    bc = ch3(beta)
    G = jnp.cumsum(ch3(g), axis=-1)
    tri = jnp.tril(jnp.ones((CHUNK, CHUNK), bool))
    strict = jnp.tril(jnp.ones((CHUNK, CHUNK), bool), -1)
    decay = jnp.exp(jnp.where(tri, G[..., :, None] - G[..., None, :], -jnp.inf))
    kk = jnp.einsum('nbhcd,nbhsd->nbhcs', kc, kc)
    A = jnp.where(strict, bc[..., None] * kk * decay, 0.0) + jnp.eye(CHUNK, dtype=jnp.float32)
    rhs = jnp.concatenate([vc * bc[..., None], kc * (bc * jnp.exp(G))[..., None]], axis=-1)
    sol = lax.linalg.triangular_solve(A, rhs, left_side=True, lower=True, unit_diagonal=True)
    u_base, w_dec = sol[..., :Dv], sol[..., Dv:]
    qk = jnp.einsum('nbhcd,nbhsd->nbhcs', qc, kc) * decay
    q_dec = qc * jnp.exp(G)[..., None]
    k_tail = kc * jnp.exp(G[..., -1:] - G)[..., None]
    a_tail = jnp.exp(G[..., -1])

    def step(S, xs):
        u_b, w_d, qk_i, qd, kt, at = xs
        u = u_b - jnp.einsum('bhcd,bhdv->bhcv', w_d, S)
        o = jnp.einsum('bhcd,bhdv->bhcv', qd, S) + jnp.einsum('bhcs,bhsv->bhcv', qk_i, u)
        S = S * at[..., None, None] + jnp.einsum('bhcd,bhcv->bhdv', kt, u)
        return S, o

    S0 = jnp.zeros((B, H, Dk, Dv), jnp.float32)
    _, o = lax.scan(step, S0, (u_base, w_dec, qk, q_dec, k_tail, a_tail))
    return o.transpose(1, 0, 3, 2, 4).reshape(B, L, H, Dv)


def gated_deltanet(q, k, v, b, a, z, conv_w, a_log, dt_bias, onorm_g):
    B, L, _ = q.shape
    dt = q.dtype
    qkv = jax.nn.silu(short_conv(jnp.concatenate([q, k, v], axis=-1), conv_w))
    qs, ks, vs = jnp.split(qkv, [B_QK, 2 * B_QK], axis=-1)
    qs = l2norm(qs.reshape(B, L, B_HEADS, B_K_DIM))
    ks = l2norm(ks.reshape(B, L, B_HEADS, B_K_DIM))
    vs = vs.reshape(B, L, B_HEADS, B_V_DIM).astype(jnp.float32)
    beta = jax.nn.sigmoid(b.astype(jnp.float32))
    g = -jnp.exp(a_log.astype(jnp.float32)) * jax.nn.softplus(a.astype(jnp.float32) + dt_bias.astype(jnp.float32))
    o = gated_delta_rule(qs, ks, vs, g, beta)
    o = rmsnorm(o, onorm_g) * jax.nn.silu(z.reshape(B, L, B_HEADS, B_V_DIM).astype(jnp.float32))
    return o.reshape(B, L, B_VW).astype(dt)


def _w(k, shape, fan_in):
    return jax.random.normal(k, shape, jnp.float32) * (fan_in ** -0.5)


def _gain(k, shape):
    return 1.0 + 0.02 * jax.random.normal(k, shape, jnp.float32)


def setup_inputs(seed: int = 0) -> dict:
    key = jax.random.key(seed)
    ks = jax.random.split(key, 24)
    Dp = DEPTH
    dt0 = jnp.exp(jax.random.uniform(ks[14], (Dp, B_HEADS), jnp.float32, np.log(1e-3), np.log(1e-1)))
    return {
        "x": jax.random.normal(ks[0], (BATCH, SEQ, D_MODEL), jnp.float32),
        "mix_norm_g": _gain(ks[1], (Dp, D_MODEL)),
        "w_in": _w(ks[2], (Dp, D_MODEL, IN_WIDTH), D_MODEL),
        "cq_norm_g": _gain(ks[3], (Dp, A_Q_RANK)),
        "ckv_norm_g": _gain(ks[4], (Dp, A_KV_RANK)),
        "w_uq": _w(ks[5], (Dp, A_Q_RANK, A_HEADS * A_QK_DIM), A_Q_RANK),
        "w_uk": _w(ks[6], (Dp, A_HEADS, A_QK_DIM, A_KV_RANK), A_KV_RANK),
        "w_uv": _w(ks[7], (Dp, A_HEADS, A_KV_RANK, A_V_DIM), A_KV_RANK),
        "w_iq": _w(ks[8], (Dp, A_Q_RANK, IDX_HEADS * IDX_DIM), A_Q_RANK),
        "kidx_ln_g": _gain(ks[9], (Dp, IDX_DIM)),
        "kidx_ln_b": 0.02 * jax.random.normal(ks[10], (Dp, IDX_DIM), jnp.float32),
        "w_branch_a": _w(ks[11], (Dp, A_WIDTH, D_MODEL), A_WIDTH),
        "conv_w": _w(ks[12], (Dp, CONV_WIDTH, 2 * B_QK + B_VW), CONV_WIDTH),
        "a_log": jnp.log(jax.random.uniform(ks[13], (Dp, B_HEADS), jnp.float32, 1.0, 16.0)),
        "dt_bias": dt0 + jnp.log(-jnp.expm1(-dt0)),
        "onorm_g": _gain(ks[15], (Dp, B_V_DIM)),
        "w_branch_b": _w(ks[16], (Dp, B_VW, D_MODEL), B_VW),
        "w_out": _w(ks[17], (Dp, D_MODEL, D_MODEL), D_MODEL),
        "ffn_norm_g": _gain(ks[18], (Dp, D_MODEL)),
        "w_gate": _w(ks[19], (Dp, D_MODEL, D_FF), D_MODEL),
        "w_up": _w(ks[20], (Dp, D_MODEL, D_FF), D_MODEL),
        "w_down": _w(ks[21], (Dp, D_FF, D_MODEL), D_FF),
        "final_norm_g": _gain(ks[22], (D_MODEL,)),
    }


def reference(x, mix_norm_g, w_in, cq_norm_g, ckv_norm_g, w_uq, w_uk, w_uv, w_iq,
              kidx_ln_g, kidx_ln_b, w_branch_a, conv_w, a_log, dt_bias, onorm_g,
              w_branch_b, w_out, ffn_norm_g, w_gate, w_up, w_down, final_norm_g):
    splits = [int(s) for s in np.cumsum(IN_SIZES)[:-1]]
    for l in range(DEPTH):
        h = rmsnorm(x, mix_norm_g[l])
        proj = h @ w_in[l]
        (c_q, c_kv, k_idx, w_idx, q_b, k_b, v_b, beta_b, a_b, z_b,
         gate_a, gate_b) = jnp.split(proj, splits, axis=-1)
        o_a = dsa_attention(c_q, c_kv, k_idx, w_idx, cq_norm_g[l], ckv_norm_g[l],
                            w_uq[l], w_uk[l], w_uv[l], w_iq[l], kidx_ln_g[l], kidx_ln_b[l])
        o_b = gated_deltanet(q_b, k_b, v_b, beta_b, a_b, z_b, conv_w[l], a_log[l],
                             dt_bias[l], onorm_g[l])
        merged = (jax.nn.sigmoid(gate_a) * (o_a @ w_branch_a[l])
                  + jax.nn.sigmoid(gate_b) * (o_b @ w_branch_b[l]))
        x = x + merged @ w_out[l]
        h = rmsnorm(x, ffn_norm_g[l])
        x = x + (jax.nn.silu(h @ w_gate[l]) * (h @ w_up[l])) @ w_down[l]
    return rmsnorm(x, final_norm_g)
```

```cpp
#include <hip/hip_runtime.h>
#include <cstdio>
#include <cstdint>

#define GAS __attribute__((address_space(1)))
#define LAS __attribute__((address_space(3)))
typedef unsigned short h16s;
typedef _Float16 h16;
typedef h16 h16x8 __attribute__((ext_vector_type(8)));
typedef h16 h16x4 __attribute__((ext_vector_type(4)));
typedef h16 h16x2 __attribute__((ext_vector_type(2)));
typedef float f32x2 __attribute__((ext_vector_type(2)));
typedef float f32x4 __attribute__((ext_vector_type(4)));
typedef float f32x16 __attribute__((ext_vector_type(16)));
typedef unsigned u32x4 __attribute__((ext_vector_type(4)));
typedef unsigned u32x2 __attribute__((ext_vector_type(2)));

__device__ __forceinline__ unsigned pkh(float lo, float hi) { f32x2 v = {lo, hi}; h16x2 h = __builtin_convertvector(v, h16x2); return __builtin_bit_cast(unsigned, h); }
__device__ __forceinline__ f32x2 unpkh(unsigned u) { h16x2 h = __builtin_bit_cast(h16x2, u); return (f32x2){(float)h[0], (float)h[1]}; }
__device__ __forceinline__ float h2f(h16s s) { return (float)__builtin_bit_cast(h16, s); }
__device__ __forceinline__ h16s f2h(float f) { return __builtin_bit_cast(h16s, (h16)f); }
__device__ __forceinline__ float sigmoidf_(float x) { return __builtin_amdgcn_rcpf(1.f + __expf(-x)); }
__device__ __forceinline__ float siluf_(float x) { return x * __builtin_amdgcn_rcpf(1.f + __expf(-x)); }

namespace pg8 {
#define PG8_LAS __attribute__((address_space(3)))
typedef unsigned short bf16_t;
constexpr int BM = 256, BK = 64, HALF = 128, HTB = HALF * BK * 2  , STAGE_BYTES = 8 * HTB, NXCD = 8, WGM = 8;

__host__ __device__ __forceinline__ int lds_byte(int r, int c) { const int st = (r >> 4) * 2 + (c >> 5), rr = r & 15, cc = c & 31, ob = rr * 64 + cc * 2; return st * 1024 + (ob ^ (((ob >> 9) & 1) << 5)); }
__host__ __device__ __forceinline__ void stage_rc(int b, int& R, int& C) { const int st = b / 1024, sb = b % 1024, swz = sb ^ (((sb >> 9) & 1) << 5); R = (st >> 1) * 16 + swz / 64; C = (st & 1) * 32 + (swz % 64) / 2; }
__host__ __device__ __forceinline__ int perm32(int rho) { const int n = rho >> 4, i = rho & 15; return 8 * (i >> 2) + 4 * n + (i & 3); }

struct Unit { int pm, pn; };
struct Gemm { const bf16_t* A; const bf16_t* Bt; int M, N, K, lda, ldb; };

struct StaticOrder {
    int nM, nN, nwg, G, c;
    __host__ __device__ void init(int M, int N, int G_, int c_) { nM = M / BM; nN = N / BM; nwg = nM * nN; G = G_; c = c_; }
    __host__ __device__ bool next(int i, Unit& u) const {
        const long L = (long)i * G + c; if (L >= nwg) return false;
        int wgid = (int)L; { const int q = nwg / NXCD, r = nwg % NXCD, xcd = wgid % NXCD, off = wgid / NXCD; wgid = (xcd < r ? xcd * (q + 1) : r * (q + 1) + (xcd - r) * q) + off; }
        const int nig = WGM * nN, gid = wgid / nig, fm = gid * WGM, gsz = (nM - fm) < WGM ? (nM - fm) : WGM;
        u.pm = fm + ((wgid % nig) % gsz); u.pn = (wgid % nig) / gsz; return true;
    }
    __device__ __forceinline__ void a_ready(const Unit&) const {}
    __device__ __forceinline__ void done(const Unit&) const {}
};

__device__ __forceinline__ u32x4 pack8(const f32x4& a, const f32x4& b) { u32x4 w; w.x = pkh(a[0], a[1]); w.y = pkh(a[2], a[3]); w.z = pkh(b[0], b[1]); w.w = pkh(b[2], b[3]); return w; }

struct EpiF16 {
    static constexpr bool PERM = true, AFTER_DRAIN = false;
    bf16_t* O; int ldc;
    __device__ __forceinline__ void operator()(const f32x4 (&acc)[2][2][4][2], const Unit& u, int wr, int wc, int fr, int fq) const {
        const int row0 = u.pm * BM + wr * 64 + fr, col0 = u.pn * BM + wc * 32 + 8 * fq;
#pragma unroll
        for (int ai = 0; ai < 2; ++ai)
#pragma unroll
            for (int m = 0; m < 4; ++m) { bf16_t* rowp = O + (size_t)(row0 + ai * HALF + m * 16) * ldc + col0;
#pragma unroll
                for (int bj = 0; bj < 2; ++bj) *(u32x4*)(rowp + bj * HALF) = pack8(acc[ai][bj][m][0], acc[ai][bj][m][1]); }
    }
};
struct EpiProj {
    static constexpr bool PERM = true, AFTER_DRAIN = false;
    bf16_t *PQ, *PQKV, *PZ, *PG; float* PS32;
    __device__ __forceinline__ void operator()(const f32x4 (&acc)[2][2][4][2], const Unit& u, int wr, int wc, int fr, int fq) const {
        const int row0 = u.pm * BM + wr * 64 + fr, cw = wc * 32 + 8 * fq;
        if (u.pn == 26) {
#pragma unroll
            for (int ai = 0; ai < 2; ++ai)
#pragma unroll
                for (int m = 0; m < 4; ++m) { float* rowp = PS32 + (size_t)(row0 + ai * HALF + m * 16) * 256 + cw;
#pragma unroll
                    for (int bj = 0; bj < 2; ++bj) { *(f32x4*)(rowp + bj * HALF) = acc[ai][bj][m][0]; *(f32x4*)(rowp + bj * HALF + 4) = acc[ai][bj][m][1]; } }
        } else {
            bf16_t* base; int ldc, c0;
            if (u.pn < 2) { base = PQ; ldc = 512; c0 = u.pn * 256; } else if (u.pn < 14) { base = PQKV; ldc = 3072; c0 = (u.pn - 2) * 256; }
            else if (u.pn < 18) { base = PZ; ldc = 1024; c0 = (u.pn - 14) * 256; } else { base = PG; ldc = 2048; c0 = (u.pn - 18) * 256; }
#pragma unroll
            for (int ai = 0; ai < 2; ++ai)
#pragma unroll
                for (int m = 0; m < 4; ++m) { bf16_t* rowp = base + (size_t)(row0 + ai * HALF + m * 16) * ldc + c0 + cw;
#pragma unroll
                    for (int bj = 0; bj < 2; ++bj) *(u32x4*)(rowp + bj * HALF) = pack8(acc[ai][bj][m][0], acc[ai][bj][m][1]); }
        }
    }
};
struct EpiGateA {
    static constexpr bool PERM = true, AFTER_DRAIN = false;
    bf16_t* PG;
    __device__ __forceinline__ void operator()(const f32x4 (&acc)[2][2][4][2], const Unit& u, int wr, int wc, int fr, int fq) const {
        const int row0 = u.pm * BM + wr * 64 + fr, col0 = u.pn * BM + wc * 32 + 8 * fq;
#pragma unroll
        for (int ai = 0; ai < 2; ++ai)
#pragma unroll
            for (int m = 0; m < 4; ++m) { bf16_t* rowp = PG + (size_t)(row0 + ai * HALF + m * 16) * 2048 + col0;
#pragma unroll
                for (int bj = 0; bj < 2; ++bj) { const u32x4 g = *(const u32x4*)(rowp + bj * HALF); f32x4 o0, o1;
                    const f32x2 g0 = unpkh(g.x), g1 = unpkh(g.y), g2 = unpkh(g.z), g3 = unpkh(g.w);
                    o0[0] = sigmoidf_(g0[0]) * acc[ai][bj][m][0][0]; o0[1] = sigmoidf_(g0[1]) * acc[ai][bj][m][0][1]; o0[2] = sigmoidf_(g1[0]) * acc[ai][bj][m][0][2]; o0[3] = sigmoidf_(g1[1]) * acc[ai][bj][m][0][3];
                    o1[0] = sigmoidf_(g2[0]) * acc[ai][bj][m][1][0]; o1[1] = sigmoidf_(g2[1]) * acc[ai][bj][m][1][1]; o1[2] = sigmoidf_(g3[0]) * acc[ai][bj][m][1][2]; o1[3] = sigmoidf_(g3[1]) * acc[ai][bj][m][1][3];
                    *(u32x4*)(rowp + bj * HALF) = pack8(o0, o1); } }
    }
};
struct EpiMerge {
    static constexpr bool PERM = true, AFTER_DRAIN = false;
    bf16_t* PG;
    __device__ __forceinline__ void operator()(const f32x4 (&acc)[2][2][4][2], const Unit& u, int wr, int wc, int fr, int fq) const {
        const int row0 = u.pm * BM + wr * 64 + fr, col0 = u.pn * BM + wc * 32 + 8 * fq;
#pragma unroll
        for (int ai = 0; ai < 2; ++ai)
#pragma unroll
            for (int m = 0; m < 4; ++m) { bf16_t* rowp = PG + (size_t)(row0 + ai * HALF + m * 16) * 2048 + col0;
#pragma unroll
                for (int bj = 0; bj < 2; ++bj) { const u32x4 t = *(const u32x4*)(rowp + bj * HALF); const u32x4 g = *(const u32x4*)(rowp + 1024 + bj * HALF); f32x4 o0, o1;
                    const f32x2 g0 = unpkh(g.x), g1 = unpkh(g.y), g2 = unpkh(g.z), g3 = unpkh(g.w), t0 = unpkh(t.x), t1 = unpkh(t.y), t2 = unpkh(t.z), t3 = unpkh(t.w);
                    o0[0] = t0[0] + sigmoidf_(g0[0]) * acc[ai][bj][m][0][0]; o0[1] = t0[1] + sigmoidf_(g0[1]) * acc[ai][bj][m][0][1]; o0[2] = t1[0] + sigmoidf_(g1[0]) * acc[ai][bj][m][0][2]; o0[3] = t1[1] + sigmoidf_(g1[1]) * acc[ai][bj][m][0][3];
                    o1[0] = t2[0] + sigmoidf_(g2[0]) * acc[ai][bj][m][1][0]; o1[1] = t2[1] + sigmoidf_(g2[1]) * acc[ai][bj][m][1][1]; o1[2] = t3[0] + sigmoidf_(g3[0]) * acc[ai][bj][m][1][2]; o1[3] = t3[1] + sigmoidf_(g3[1]) * acc[ai][bj][m][1][3];
                    *(u32x4*)(rowp + 1024 + bj * HALF) = pack8(o0, o1); } }
    }
};
struct EpiRes {
    static constexpr bool PERM = false, AFTER_DRAIN = false;
    const float* base; float* out;
    __device__ __forceinline__ void operator()(const f32x4 (&acc)[2][2][4][2], const Unit& u, int wr, int wc, int fr, int fq) const {
        const int row0 = u.pm * BM + wr * 64 + fr, col0 = u.pn * BM + wc * 32 + 4 * fq;
#pragma unroll
        for (int ai = 0; ai < 2; ++ai)
#pragma unroll
            for (int m = 0; m < 4; ++m) { const size_t off = (size_t)(row0 + ai * HALF + m * 16) * 1024 + col0;
#pragma unroll
                for (int bj = 0; bj < 2; ++bj)
#pragma unroll
                    for (int n = 0; n < 2; ++n) { const f32x4 b = *(const f32x4*)(base + off + bj * HALF + n * 16); *(f32x4*)(out + off + bj * HALF + n * 16) = b + acc[ai][bj][m][n]; } }
    }
};
struct EpiSwiglu {
    static constexpr bool PERM = true, AFTER_DRAIN = false;
    bf16_t* ACT;
    __device__ __forceinline__ void operator()(const f32x4 (&acc)[2][2][4][2], const Unit& u, int wr, int wc, int fr, int fq) const {
        const int row0 = u.pm * BM + wr * 64 + fr, col0 = u.pn * HALF + wc * 32 + 8 * fq;
#pragma unroll
        for (int ai = 0; ai < 2; ++ai)
#pragma unroll
            for (int m = 0; m < 4; ++m) { f32x4 o0, o1;
#pragma unroll
                for (int e = 0; e < 4; ++e) { o0[e] = siluf_(acc[ai][0][m][0][e]) * acc[ai][1][m][0][e]; o1[e] = siluf_(acc[ai][0][m][1][e]) * acc[ai][1][m][1][e]; }
                *(u32x4*)(ACT + (size_t)(row0 + ai * HALF + m * 16) * 2816 + col0) = pack8(o0, o1); }
    }
};

template <class Epi, class Sched, bool ALIGN_EPI = false, bool SP2 = false>
__device__ __forceinline__ void gemm_phase(PG8_LAS unsigned char* lds, const Gemm g, const Sched& S, const Epi& E) {
    const int tid = threadIdx.x, wid = __builtin_amdgcn_readfirstlane(tid >> 6), lane = tid & 63, wr = wid >> 2, wc = wid & 3, fr = lane & 15, fq = lane >> 4;
    int K = g.K; asm volatile("" : "+s"(K));
    const int nt = K / BK;
    unsigned voffA[2], voffB[2];
#pragma unroll
    for (int i = 0; i < 2; ++i) { int R, C; stage_rc(tid * 16 + i * 8192, R, C); const int Rb = Epi::PERM ? ((R & ~31) + perm32(R & 31)) : R;
        voffA[i] = (unsigned)(R * g.lda + C) * 2u; voffB[i] = (unsigned)(Rb * g.ldb + C) * 2u; }
    const size_t kstep = (size_t)(BK * 2);
    const size_t hstepA = (size_t)HALF * g.lda * 2, hstepB = (size_t)HALF * g.ldb * 2;
    const size_t tstepA = 2 * hstepA, tstepB = 2 * hstepB;
    const unsigned ldsw = (unsigned)wid * 1024u;
    const int aoff = lds_byte(wr * 64 + fr, fq * 8), boff = lds_byte(wc * 32 + fr, fq * 8);
#define PG8_SA(b, h) (((b) * 2 + (h)) * HTB)
#define PG8_SB(b, h) ((4 + (b) * 2 + (h)) * HTB)
#define PG8_STAGE(bufoff, gbase, voff) do { _Pragma("unroll") for (int _i = 0; _i < 2; ++_i) \
        __builtin_amdgcn_global_load_lds((const unsigned*)((const char*)(gbase) + (voff)[_i]), (PG8_LAS unsigned*)(lds + (bufoff) + ldsw + _i * 8192), 16, 0, 0); } while (0)
#define PG8_LDA(dst, b, h) do { _Pragma("unroll") for (int m = 0; m < 4; ++m) _Pragma("unroll") for (int k = 0; k < 2; ++k) dst[m][k] = *(const PG8_LAS h16x8*)(lds + PG8_SA(b, h) + aoff + m * 2048 + k * 1024); } while (0)
#define PG8_LDB(dst, b, h) do { _Pragma("unroll") for (int n = 0; n < 2; ++n) _Pragma("unroll") for (int k = 0; k < 2; ++k) dst[n][k] = *(const PG8_LAS h16x8*)(lds + PG8_SB(b, h) + boff + n * 2048 + k * 1024); } while (0)
#define PG8_MMA(ai, bj, At, Bt) do { __builtin_amdgcn_s_setprio(1); _Pragma("unroll") for (int m = 0; m < 4; ++m) _Pragma("unroll") for (int n = 0; n < 2; ++n) _Pragma("unroll") for (int k = 0; k < 2; ++k) \
        acc[ai][bj][m][n] = __builtin_amdgcn_mfma_f32_16x16x32_f16(Bt[n][k], At[m][k], acc[ai][bj][m][n], 0, 0, 0); __builtin_amdgcn_s_setprio(0); } while (0)
#define PG8_WAIT_V(n) asm volatile("s_waitcnt vmcnt(" #n ")" ::: "memory")
#define PG8_WAIT_L(n) asm volatile("s_waitcnt lgkmcnt(" #n ")" ::: "memory")
#define PG8_BAR __builtin_amdgcn_s_barrier()
#define PG8_SCHED __builtin_amdgcn_sched_barrier(0)
    Unit cur, nxt; int ui = 0;
    if (!S.next(0, cur)) return;
    f32x4 acc[2][2][4][2];
#pragma unroll
    for (int a = 0; a < 2; ++a)
#pragma unroll
        for (int b = 0; b < 2; ++b)
#pragma unroll
            for (int m = 0; m < 4; ++m)
#pragma unroll
                for (int n = 0; n < 2; ++n) acc[a][b][m][n] = (f32x4){0.f, 0.f, 0.f, 0.f};
    h16x8 At[4][2], B0[2][2], B1[2][2];
    const char* cA = (const char*)g.A + (size_t)cur.pm * tstepA; const char* cB = (const char*)g.Bt + (size_t)cur.pn * tstepB;
    S.a_ready(cur);
    if constexpr (SP2) {
        PG8_STAGE(PG8_SB(0, 0), cB, voffB); PG8_STAGE(PG8_SB(0, 1), cB + hstepB, voffB); PG8_STAGE(PG8_SA(0, 0), cA, voffA); PG8_STAGE(PG8_SA(0, 1), cA + hstepA, voffA);
        if (wr == 1) PG8_BAR;
        PG8_WAIT_V(2); PG8_BAR;
        PG8_STAGE(PG8_SB(1, 0), cB + kstep, voffB); PG8_STAGE(PG8_SA(1, 0), cA + kstep, voffA); PG8_STAGE(PG8_SB(1, 1), cB + hstepB + kstep, voffB);
        PG8_WAIT_V(6); PG8_BAR;
    } else {
        PG8_STAGE(PG8_SB(0, 0), cB, voffB); PG8_STAGE(PG8_SA(0, 0), cA, voffA); PG8_STAGE(PG8_SB(0, 1), cB + hstepB, voffB); PG8_STAGE(PG8_SA(0, 1), cA + hstepA, voffA);
        if (wr == 1) PG8_BAR;
        PG8_WAIT_V(4); PG8_BAR;
        PG8_STAGE(PG8_SB(1, 0), cB + kstep, voffB); PG8_STAGE(PG8_SA(1, 0), cA + kstep, voffA); PG8_STAGE(PG8_SB(1, 1), cB + hstepB + kstep, voffB);
        PG8_WAIT_V(6); PG8_BAR;
    }
    for (;;) {
        const bool has_next = S.next(ui + 1, nxt);
        const char* nA = has_next ? (const char*)g.A + (size_t)nxt.pm * tstepA : cA; const char* nB = has_next ? (const char*)g.Bt + (size_t)nxt.pn * tstepB : cB;
        for (int t = 0; t < nt; t += 2) {
            const bool last = (t == nt - 2);
            const char* a1 = cA + (size_t)(t + 1) * kstep;
            const char* a2 = last ? nA : cA + (size_t)(t + 2) * kstep; const char* b2 = last ? nB : cB + (size_t)(t + 2) * kstep;
            const char* a3 = a2 + kstep; const char* b3 = b2 + kstep;
            if (last && has_next) S.a_ready(nxt);
            if constexpr (SP2) {
            PG8_LDB(B0, 0, 0); PG8_LDB(B1, 0, 1); PG8_SCHED; PG8_LDA(At, 0, 0); PG8_STAGE(PG8_SA(1, 1), a1 + hstepA, voffA);
            PG8_WAIT_V(8); PG8_WAIT_L(0); PG8_BAR; PG8_MMA(0, 0, At, B0); PG8_MMA(0, 1, At, B1); PG8_BAR; PG8_SCHED;
            PG8_LDA(At, 0, 1); PG8_STAGE(PG8_SB(0, 0), b2, voffB); PG8_STAGE(PG8_SB(0, 1), b2 + hstepB, voffB); PG8_STAGE(PG8_SA(0, 0), a2, voffA);
            PG8_WAIT_V(8); PG8_WAIT_L(0); PG8_BAR; PG8_MMA(1, 0, At, B0); PG8_MMA(1, 1, At, B1); PG8_BAR; PG8_SCHED;
            PG8_LDB(B0, 1, 0); PG8_LDB(B1, 1, 1); PG8_SCHED; PG8_LDA(At, 1, 0); PG8_STAGE(PG8_SA(0, 1), a2 + hstepA, voffA);
            PG8_WAIT_V(8); PG8_WAIT_L(0); PG8_BAR; PG8_MMA(0, 0, At, B0); PG8_MMA(0, 1, At, B1); PG8_BAR; PG8_SCHED;
            PG8_LDA(At, 1, 1); PG8_STAGE(PG8_SB(1, 0), b3, voffB); PG8_STAGE(PG8_SB(1, 1), b3 + hstepB, voffB); PG8_STAGE(PG8_SA(1, 0), a3, voffA);
            PG8_WAIT_V(8); PG8_WAIT_L(0); PG8_BAR; PG8_MMA(1, 0, At, B0); PG8_MMA(1, 1, At, B1); PG8_BAR; PG8_SCHED;
            } else {
            PG8_LDB(B0, 0, 0); PG8_SCHED; PG8_LDA(At, 0, 0); PG8_STAGE(PG8_SA(1, 1), a1 + hstepA, voffA);
            PG8_WAIT_L(8); PG8_BAR; PG8_WAIT_L(0); PG8_MMA(0, 0, At, B0); PG8_BAR; PG8_SCHED;
            PG8_LDB(B1, 0, 1); PG8_STAGE(PG8_SB(0, 0), b2, voffB);
            PG8_BAR; PG8_WAIT_L(0); PG8_MMA(0, 1, At, B1); PG8_BAR;
            PG8_LDA(At, 0, 1); PG8_STAGE(PG8_SA(0, 0), a2, voffA);
            PG8_BAR; PG8_WAIT_L(0); PG8_MMA(1, 0, At, B0); PG8_BAR; PG8_SCHED;
            PG8_STAGE(PG8_SB(0, 1), b2 + hstepB, voffB);
            PG8_WAIT_V(6); PG8_BAR; PG8_MMA(1, 1, At, B1); PG8_BAR;
            PG8_LDB(B0, 1, 0); PG8_SCHED; PG8_LDA(At, 1, 0); PG8_STAGE(PG8_SA(0, 1), a2 + hstepA, voffA);
            PG8_WAIT_L(8); PG8_BAR; PG8_WAIT_L(0); PG8_MMA(0, 0, At, B0); PG8_BAR; PG8_SCHED;
            PG8_LDB(B1, 1, 1); PG8_STAGE(PG8_SB(1, 0), b3, voffB);
            PG8_BAR; PG8_WAIT_L(0); PG8_MMA(0, 1, At, B1); PG8_BAR;
            PG8_LDA(At, 1, 1); PG8_STAGE(PG8_SA(1, 0), a3, voffA);
            PG8_BAR; PG8_WAIT_L(0); PG8_MMA(1, 0, At, B0); PG8_BAR; PG8_SCHED;
            PG8_STAGE(PG8_SB(1, 1), b3 + hstepB, voffB);
            PG8_WAIT_V(6); PG8_BAR; PG8_MMA(1, 1, At, B1); PG8_BAR;
            }
        }
        if constexpr (ALIGN_EPI) { if (wr == 0) PG8_BAR; }
        if constexpr (!Epi::AFTER_DRAIN) { E(acc, cur, wr, wc, fr, fq); S.done(cur); }
        if (!has_next) break;
#pragma unroll
        for (int a = 0; a < 2; ++a)
#pragma unroll
            for (int b = 0; b < 2; ++b)
#pragma unroll
                for (int m = 0; m < 4; ++m)
#pragma unroll
                    for (int n = 0; n < 2; ++n) acc[a][b][m][n] = (f32x4){0.f, 0.f, 0.f, 0.f};
        cur = nxt; cA = nA; cB = nB; ++ui;
        if constexpr (ALIGN_EPI) { if (wr == 1) PG8_BAR; }
    }
    PG8_WAIT_V(0);
    if constexpr (!ALIGN_EPI) { if (wr == 0) PG8_BAR; }
    PG8_BAR;
    if constexpr (Epi::AFTER_DRAIN) { E.fused(acc, cur, wr, wc, fr, fq, lds, wid, lane); S.done(cur); }
#undef PG8_SA
#undef PG8_SB
#undef PG8_STAGE
#undef PG8_LDA
#undef PG8_LDB
#undef PG8_MMA
#undef PG8_WAIT_V
#undef PG8_WAIT_L
#undef PG8_BAR
#undef PG8_SCHED
}
}
#define XB_TMO      128
#define XB_XCNT(j)  (256  + 64 * (j))
#define XB_XSUB(j)  (1280 + 64 * (j))
#define XB_XGEN(j)  (2304 + 64 * (j))
#define XB_TOP      3328
#define XB_TOPGEN   3392
#define XCD_BAR_WORDS 3456
#define XB_SPIN_CAP (1u << 23)

__device__ __forceinline__ unsigned xb_ld(unsigned* p)              { return __hip_atomic_load(p, __ATOMIC_RELAXED, __HIP_MEMORY_SCOPE_AGENT); }
__device__ __forceinline__ unsigned xb_add(unsigned* p, unsigned v) { return __hip_atomic_fetch_add(p, v, __ATOMIC_RELAXED, __HIP_MEMORY_SCOPE_AGENT); }
__device__ __forceinline__ unsigned xb_xcc_id() { return (unsigned)__builtin_amdgcn_s_getreg((3 << 11) | 20) & 0xFu; }
#define XB_SPIN(cond, bar) do { unsigned _sp = 0; while (cond) { __builtin_amdgcn_s_sleep(1); \
    if ((++_sp & 255u) == 0u) { if (xb_ld(&(bar)[XB_TMO])) break; if (_sp > XB_SPIN_CAP) { atomicAdd(&(bar)[XB_TMO], 1u); break; } } } } while (0)

struct XcdBarrier {
    unsigned* bar; unsigned x;
    volatile LAS unsigned* st;
};

__device__ __forceinline__ XcdBarrier xcd_barrier_post(unsigned* bar, volatile LAS unsigned* st) {
    XcdBarrier b; b.bar = bar; b.x = xb_xcc_id(); b.st = st;
    if (threadIdx.x == 0) (void)xb_add(&bar[XB_XCNT(b.x)], 1u);
    return b;
}
__device__ __forceinline__ void xcd_barrier_complete(unsigned* bar, unsigned x, unsigned& nloc, unsigned& nx) {
    const unsigned G = gridDim.x * gridDim.y * gridDim.z;
    unsigned sum, cnt, mine, sp = 0u;
    for (;;) {
        sum = 0u; cnt = 0u; mine = 0u;
#pragma unroll
        for (unsigned j = 0; j < 16; ++j) { const unsigned c = xb_ld(&bar[XB_XCNT(j)]); sum += c; cnt += (c > 0u) ? 1u : 0u; mine = (j == x) ? c : mine; }
        if (sum == G) break;
        __builtin_amdgcn_s_sleep(1);
        if ((++sp & 255u) == 0u) { if (xb_ld(&bar[XB_TMO])) break; if (sp > XB_SPIN_CAP) { atomicAdd(&bar[XB_TMO], 1u); break; } }
    }
    nloc = mine > 0u ? mine : 1u; nx = cnt > 0u ? cnt : 1u;
}

__device__ __forceinline__ void xcd_barrier(const XcdBarrier& b) {
    asm volatile("s_waitcnt vmcnt(0)" ::: "memory");
    __syncthreads();
    if (threadIdx.x == 0) {
        unsigned* bar = b.bar;
        __builtin_amdgcn_s_waitcnt(0);
        unsigned nloc = b.st[0], nx = b.st[1];
        if (nloc == 0u) { xcd_barrier_complete(bar, b.x, nloc, nx); b.st[0] = nloc; b.st[1] = nx; }
        const unsigned old = xb_add(&bar[XB_XSUB(b.x)], 1u);
        const unsigned gen = old / nloc;
        if (old + 1u == (gen + 1u) * nloc) {
            __builtin_amdgcn_fence(__ATOMIC_RELEASE, "agent");
            asm volatile("s_waitcnt vmcnt(0)" ::: "memory");
            const unsigned og = xb_add(&bar[XB_TOP], 1u);
            const unsigned tg = og / nx;
            if (og + 1u == (tg + 1u) * nx) xb_add(&bar[XB_TOPGEN], 1u);
            else XB_SPIN(xb_ld(&bar[XB_TOPGEN]) == tg, bar);
            __builtin_amdgcn_fence(__ATOMIC_ACQUIRE, "agent");
            xb_add(&bar[XB_XGEN(b.x)], 1u);
            asm volatile("s_waitcnt vmcnt(0)" ::: "memory");
        } else {
            XB_SPIN(xb_ld(&bar[XB_XGEN(b.x)]) == gen, bar);
            __builtin_amdgcn_fence(__ATOMIC_ACQUIRE, "agent");
            asm volatile("s_waitcnt vmcnt(0)" ::: "memory");
        }
    }
    __syncthreads();
}

constexpr int NWAVES = 8;
constexpr int T = 16384, SEQ = 2048, NBATCH = 8, DM = 1024, DFF = 2816, INW = 6744, INWP = 6912;
constexpr float EPS = 1e-6f;
constexpr size_t MiB = 1u << 20;
constexpr size_t WS_CTL = 0, CTL_ZERO_BYTES = 1 * MiB;
constexpr size_t WS_WGU = 1 * MiB;
constexpr size_t WS_WDN = 12 * MiB;
constexpr size_t WS_WPA = WS_WDN + 5632 * 1024;
constexpr size_t WS_WPB = WS_WPA + 2 * MiB;
constexpr size_t WS_WOUT = WS_WPB + 2 * MiB;
constexpr size_t WS_WQI = WS_WOUT + 2 * MiB;
constexpr size_t WS_KIDX = 25 * MiB + 256 * 1024;
constexpr size_t WS_WIDX = WS_KIDX + 2 * MiB;
constexpr size_t WS_BETA = WS_WIDX + 512 * 1024;
constexpr size_t WS_GG = WS_BETA + 512 * 1024;
constexpr size_t WS_PQ = 29 * MiB;
constexpr size_t WS_PQKV = 45 * MiB;
constexpr size_t WS_PZ = 141 * MiB;
constexpr size_t WS_PG = 173 * MiB;
constexpr size_t WS_PS32 = 237 * MiB;
constexpr size_t WS_END = 253 * MiB;
constexpr size_t WS_QI = WS_PQKV;
constexpr size_t WS_SEL = WS_QI + 48 * MiB;
constexpr size_t WS_OA = WS_SEL + 16 * MiB;
constexpr size_t WS_ACT = WS_PQKV;
constexpr size_t DO_H = 0;
constexpr size_t DO_WIN = 32 * MiB;
constexpr size_t DO_HALO = 0;

constexpr int LDS_BYTES = 147456;
constexpr int RING_BYTES = 131072;
constexpr int MISC_OFF = RING_BYTES + 320;

#define LDS_WAIT() asm volatile("s_waitcnt lgkmcnt(0)" ::: "memory")
#define VM_WAIT() asm volatile("s_waitcnt vmcnt(0)" ::: "memory")

__device__ __forceinline__ float wave_sum(float v) {
#pragma unroll
    for (int o = 1; o < 64; o <<= 1) v += __shfl_xor(v, o);
    return v;
}
__device__ __forceinline__ float half_sum(float v) {
#pragma unroll
    for (int o = 1; o < 32; o <<= 1) v += __shfl_xor(v, o);
    return v;
}

struct Ctx {
    LAS unsigned char* lds;
    int tid, lane, wave, G, bid;
    const float* const* in; float* out; unsigned char* ws;
};
#define WSP(T_, off) ((T_*)(C.ws + (off)))
#define DOP(T_, off) ((T_*)((unsigned char*)C.out + (off)))

struct Src { const float* p; int ld; };
struct MapId { const float* W; int N; __device__ __forceinline__ Src operator()(int n) const { return Src{W + n, N}; } };
struct MapWin { const float* W; __device__ __forceinline__ Src operator()(int n) const {
    int c;
    if (n < 512) c = n; else if (n < 1536) c = 584 + (n - 512); else if (n < 2560) c = 1608 + (n - 1536); else if (n < 3584) c = 2632 + (n - 2560);
    else if (n < 4608) c = 3672 + (n - 3584); else if (n < 5632) c = 4696 + (n - 4608); else if (n < 6656) c = 5720 + (n - 5632);
    else { const int q = n - 6656; if (q < 64) c = 512 + q; else if (q < 72) c = 576 + (q - 64); else if (q < 80) c = 3656 + (q - 72); else if (q < 88) c = 3664 + (q - 80); else c = -1; }
    return Src{c >= 0 ? W + c : nullptr, INW}; } };
struct MapGU { const float* Wg; const float* Wu; __device__ __forceinline__ Src operator()(int n) const { const int t = n >> 8, w = n & 255; return (w < 128) ? Src{Wg + 128 * t + w, DFF} : Src{Wu + 128 * t + (w - 128), DFF}; } };
struct MapQI { const float* Wq; const float* Wi; __device__ __forceinline__ Src operator()(int n) const { return (n < 1024) ? Src{Wq + n, 1024} : Src{Wi + (n - 1024), 512}; } };

template <class Map>
__device__ __forceinline__ void tr_item(const Map& map, int K, h16s* WT, LAS float* scr, int item, int nblk, int lane) {
    const int kb = item / nblk, nb = item % nblk, k0 = 64 * kb, n0 = 32 * nb;
    const Src s = map(n0 + (lane & 31));
#pragma unroll 8
    for (int i = 0; i < 32; ++i) { const int kk = 2 * i + (lane >> 5); scr[kk * 33 + (lane & 31)] = s.p ? s.p[(size_t)(k0 + kk) * s.ld] : 0.f; }
    LDS_WAIT(); asm volatile("" ::: "memory");
    const int c = lane & 7;
#pragma unroll
    for (int j = 0; j < 4; ++j) { const int n = (lane >> 3) + 8 * j; const LAS float* q = scr + (8 * c) * 33 + n;
        u32x4 o; o.x = pkh(q[0 * 33], q[1 * 33]); o.y = pkh(q[2 * 33], q[3 * 33]); o.z = pkh(q[4 * 33], q[5 * 33]); o.w = pkh(q[6 * 33], q[7 * 33]);
        *(u32x4*)(WT + (size_t)(n0 + n) * K + k0 + 8 * c) = o; }
    LDS_WAIT(); asm volatile("" ::: "memory");
}
__device__ __forceinline__ void rms_row_f16(const float* xrow, const float* g, h16s* orow, int lane) {
    const f32x4* xr = (const f32x4*)xrow + lane; const f32x4* gr = (const f32x4*)g + lane;
    f32x4 v[4]; float s = 0.f;
#pragma unroll
    for (int j = 0; j < 4; ++j) { v[j] = xr[64 * j]; s += (v[j].x * v[j].x + v[j].y * v[j].y) + (v[j].z * v[j].z + v[j].w * v[j].w); }
    const float r = rsqrtf(wave_sum(s) * (1.f / 1024.f) + EPS);
    u32x2* o8 = (u32x2*)orow + lane;
#pragma unroll
    for (int j = 0; j < 4; ++j) { const f32x4 gg = gr[64 * j]; u32x2 w; w.x = pkh(v[j].x * r * gg.x, v[j].y * r * gg.y); w.y = pkh(v[j].z * r * gg.z, v[j].w * r * gg.w); o8[64 * j] = w; }
}
__device__ __forceinline__ void p0_prologue(Ctx& C) {
    LAS float* scr = (LAS float*)(C.lds + C.wave * 16384);
    const int gw = C.bid * NWAVES + C.wave, NGW = C.G * NWAVES;
    constexpr int I_IN = 16 * (INWP / 32), I_GU = 16 * (5632 / 32), I_DN = 44 * 32, I_SQ = 16 * 32, I_QI = 4 * 48;
    constexpr int NITEMS = I_IN + I_GU + I_DN + 3 * I_SQ + I_QI;
    for (int it = gw; it < NITEMS; it += NGW) {
        int r = it;
        if (r < I_IN) { tr_item(MapWin{C.in[2]}, 1024, DOP(h16s, DO_WIN), scr, r, INWP / 32, C.lane); continue; } r -= I_IN;
        if (r < I_GU) { tr_item(MapGU{C.in[19], C.in[20]}, 1024, WSP(h16s, WS_WGU), scr, r, 5632 / 32, C.lane); continue; } r -= I_GU;
        if (r < I_DN) { tr_item(MapId{C.in[21], 1024}, 2816, WSP(h16s, WS_WDN), scr, r, 32, C.lane); continue; } r -= I_DN;
        if (r < I_SQ) { tr_item(MapId{C.in[11], 1024}, 1024, WSP(h16s, WS_WPA), scr, r, 32, C.lane); continue; } r -= I_SQ;
        if (r < I_SQ) { tr_item(MapId{C.in[16], 1024}, 1024, WSP(h16s, WS_WPB), scr, r, 32, C.lane); continue; } r -= I_SQ;
        if (r < I_SQ) { tr_item(MapId{C.in[17], 1024}, 1024, WSP(h16s, WS_WOUT), scr, r, 32, C.lane); continue; } r -= I_SQ;
        tr_item(MapQI{C.in[5], C.in[8]}, 256, WSP(h16s, WS_WQI), scr, r, 48, C.lane);
    }
    for (int m = gw; m < T; m += NGW) rms_row_f16(C.in[0] + (size_t)m * DM, C.in[1], DOP(h16s, DO_H) + (size_t)m * DM, C.lane);
}

__device__ __forceinline__ void p2_prep(Ctx& C) {
    const int gw = C.bid * NWAVES + C.wave, NGW = C.G * NWAVES, lane = C.lane;
    const float* cqg = C.in[3]; const float* ckvg = C.in[4]; const float* lng = C.in[9]; const float* lnb = C.in[10]; const float* alog = C.in[13]; const float* dtb = C.in[14];
    for (int m = gw; m < T; m += NGW) {
        { u32x4* p = WSP(u32x4, WS_PQ) + (size_t)m * 64 + lane; const u32x4 w = *p; const float* g = (lane < 32 ? cqg : ckvg) + (lane & 31) * 8;
          const f32x2 a = unpkh(w.x), b = unpkh(w.y), c = unpkh(w.z), d = unpkh(w.w);
          const float ss = half_sum((a[0] * a[0] + a[1] * a[1]) + (b[0] * b[0] + b[1] * b[1]) + (c[0] * c[0] + c[1] * c[1]) + (d[0] * d[0] + d[1] * d[1]));
          const float r = rsqrtf(ss * (1.f / 256.f) + EPS); const f32x4 g0 = *(const f32x4*)g, g1 = *(const f32x4*)(g + 4);
          u32x4 o; o.x = pkh(a[0] * r * g0.x, a[1] * r * g0.y); o.y = pkh(b[0] * r * g0.z, b[1] * r * g0.w); o.z = pkh(c[0] * r * g1.x, c[1] * r * g1.y); o.w = pkh(d[0] * r * g1.z, d[1] * r * g1.w); *p = o; }
        const float* ps = WSP(float, WS_PS32) + (size_t)m * 256;
        { const float x = ps[lane]; const float mu = wave_sum(x) * (1.f / 64.f); const float xc = x - mu; const float var = wave_sum(xc * xc) * (1.f / 64.f);
          const float y = xc * rsqrtf(var + EPS) * lng[lane] + lnb[lane]; WSP(h16s, WS_KIDX)[(size_t)m * 64 + lane] = f2h(y); }
        if (lane < 8) {
            WSP(float, WS_WIDX)[(size_t)m * 8 + lane] = ps[64 + lane] * (0.35355339059327373f * 0.125f);
            WSP(float, WS_BETA)[(size_t)m * 8 + lane] = 1.f / (1.f + expf(-ps[72 + lane]));
            const float xa = ps[80 + lane] + dtb[lane]; const float sp = xa > 20.f ? xa : log1pf(expf(xa));
            WSP(float, WS_GG)[(size_t)m * 8 + lane] = -expf(alog[lane]) * sp;
        }
        const int t = m & (SEQ - 1), tc = t & 63, c = t >> 6;
        if (tc >= 61 && c < 31) {
            const u32x4* src = WSP(u32x4, WS_PQKV) + (size_t)m * 384; u32x4* dst = DOP(u32x4, DO_HALO) + ((size_t)((m >> 11) * 32 + c + 1) * 3 + (tc - 61)) * 384;
#pragma unroll
            for (int i = 0; i < 6; ++i) dst[i * 64 + lane] = src[i * 64 + lane];
        }
    }
}

__device__ __forceinline__ void p3_conv_inplace(Ctx& C) {
    LAS float* tile = (LAS float*)C.lds;
    const float* convw = C.in[12];
    const int tid = C.tid;
    for (int u = C.bid; u < NBATCH * 32 * 8 * 3; u += C.G) {
        const int part = u % 3, h = (u / 3) & 7, c = (u / 24) & 31, b = u / (24 * 32);
        const size_t m0 = (size_t)b * SEQ + c * 64; const int colb = part * 1024 + h * 128;
        for (int i = tid; i < 67 * 16; i += 512) { const int row = i >> 4, ch = i & 15; u32x4 w = (u32x4){0u, 0u, 0u, 0u};
            if (row >= 3) w = *(const u32x4*)(WSP(h16s, WS_PQKV) + (m0 + row - 3) * 3072 + colb + ch * 8);
            else if (c > 0) w = *(const u32x4*)(DOP(h16s, DO_HALO) + ((size_t)(b * 32 + c) * 3 + row) * 3072 + colb + ch * 8);
            const f32x2 a = unpkh(w.x), bb = unpkh(w.y), cc = unpkh(w.z), d = unpkh(w.w); LAS float* tp = tile + row * 128 + ch * 8;
            *(LAS f32x4*)tp = (f32x4){a[0], a[1], bb[0], bb[1]}; *(LAS f32x4*)(tp + 4) = (f32x4){cc[0], cc[1], d[0], d[1]}; }
        __syncthreads();
        const int r = tid >> 3, cg = tid & 7; float o[16]; float ss = 0.f;
#pragma unroll
        for (int i = 0; i < 16; ++i) { const int col = cg * 16 + i; float a = 0.f;
#pragma unroll
            for (int j = 0; j < 4; ++j) a += convw[j * 3072 + colb + col] * tile[(r + j) * 128 + col];
            a = a / (1.f + expf(-a)); o[i] = a; ss += a * a; }
        if (part < 2) { ss += __shfl_xor(ss, 1); ss += __shfl_xor(ss, 2); ss += __shfl_xor(ss, 4);
            const float sc = rsqrtf(ss + EPS) * (part == 0 ? 0.08838834764831845f : 1.f);
#pragma unroll
            for (int i = 0; i < 16; ++i) o[i] *= sc; }
        u32x4 w0, w1; w0.x = pkh(o[0], o[1]); w0.y = pkh(o[2], o[3]); w0.z = pkh(o[4], o[5]); w0.w = pkh(o[6], o[7]); w1.x = pkh(o[8], o[9]); w1.y = pkh(o[10], o[11]); w1.z = pkh(o[12], o[13]); w1.w = pkh(o[14], o[15]);
        u32x4* dst = (u32x4*)(WSP(h16s, WS_PQKV) + (m0 + r) * 3072 + colb + cg * 16); dst[0] = w0; dst[1] = w1;
        __syncthreads();
    }
}
__device__ __forceinline__ void p4_scan_naive(Ctx& C) {
    if (C.wave != 0) return;
    const int lane = C.lane;
    LAS u32x4* kq = (LAS u32x4*)C.lds;
    for (int u = C.bid; u < 256; u += C.G) {
    const int bh = u >> 2, b = bh >> 3, h = bh & 7, j = (u & 3) * 32 + (lane & 31), dh = lane >> 5;
    float S[64];
#pragma unroll
    for (int d = 0; d < 64; ++d) S[d] = 0.f;
    h16s* base = WSP(h16s, WS_PQKV) + (size_t)b * SEQ * 3072;
    for (int t0 = 0; t0 < SEQ; t0 += 16) {
#pragma unroll
        for (int i = 0; i < 8; ++i) { const int idx = i * 64 + lane, row = idx >> 5, ch = idx & 31;
            kq[idx] = *(const u32x4*)(base + (size_t)(t0 + row) * 3072 + (ch < 16 ? h * 128 + ch * 8 : 1024 + h * 128 + (ch - 16) * 8)); }
        LDS_WAIT(); asm volatile("" ::: "memory");
#pragma unroll 1
        for (int tt = 0; tt < 16; ++tt) {
            const size_t m = (size_t)b * SEQ + t0 + tt; h16s* vp = base + (size_t)(t0 + tt) * 3072 + 2048 + h * 128 + j;
            const float v = h2f(*vp), beta = WSP(float, WS_BETA)[m * 8 + h], a = expf(WSP(float, WS_GG)[m * 8 + h]);
            float dot = 0.f;
#pragma unroll
            for (int c = 0; c < 8; ++c) { const h16x8 kv = __builtin_bit_cast(h16x8, kq[tt * 32 + 16 + dh * 8 + c]);
#pragma unroll
                for (int e = 0; e < 8; ++e) dot += S[c * 8 + e] * (float)kv[e]; }
            dot += __shfl_xor(dot, 32);
            const float uu = beta * (v - a * dot); float o = 0.f;
#pragma unroll
            for (int c = 0; c < 8; ++c) { const h16x8 kv = __builtin_bit_cast(h16x8, kq[tt * 32 + 16 + dh * 8 + c]); const h16x8 qv = __builtin_bit_cast(h16x8, kq[tt * 32 + dh * 8 + c]);
#pragma unroll
                for (int e = 0; e < 8; ++e) { const float s = a * S[c * 8 + e] + (float)kv[e] * uu; S[c * 8 + e] = s; o += s * (float)qv[e]; } }
            o += __shfl_xor(o, 32);
            if (dh == 0) *vp = f2h(o);
        }
        asm volatile("" ::: "memory");
    }
    }
}
__device__ __forceinline__ void p5_gated_norm(Ctx& C) {
    const int gw = C.bid * NWAVES + C.wave, NGW = C.G * NWAVES, lane = C.lane; const float* og = C.in[15];
    for (int m = gw; m < T; m += NGW) {
#pragma unroll
        for (int p = 0; p < 2; ++p) {
            const int col = p * 512 + lane * 8;
            const u32x4 w = *(const u32x4*)(WSP(h16s, WS_PQKV) + (size_t)m * 3072 + 2048 + col); u32x4* zp = (u32x4*)(WSP(h16s, WS_PZ) + (size_t)m * 1024 + col); const u32x4 z = *zp;
            const f32x2 a = unpkh(w.x), b = unpkh(w.y), c = unpkh(w.z), d = unpkh(w.w);
            float ss = (a[0] * a[0] + a[1] * a[1]) + (b[0] * b[0] + b[1] * b[1]) + (c[0] * c[0] + c[1] * c[1]) + (d[0] * d[0] + d[1] * d[1]);
            ss += __shfl_xor(ss, 1); ss += __shfl_xor(ss, 2); ss += __shfl_xor(ss, 4); ss += __shfl_xor(ss, 8);
            const float r = rsqrtf(ss * (1.f / 128.f) + EPS); const float* g = og + (col & 127); const f32x4 g0 = *(const f32x4*)g, g1 = *(const f32x4*)(g + 4);
            const f32x2 z0 = unpkh(z.x), z1 = unpkh(z.y), z2 = unpkh(z.z), z3 = unpkh(z.w);
            u32x4 o; o.x = pkh(a[0] * r * g0.x * siluf_(z0[0]), a[1] * r * g0.y * siluf_(z0[1])); o.y = pkh(b[0] * r * g0.z * siluf_(z1[0]), b[1] * r * g0.w * siluf_(z1[1]));
            o.z = pkh(c[0] * r * g1.x * siluf_(z2[0]), c[1] * r * g1.y * siluf_(z2[1])); o.w = pkh(d[0] * r * g1.z * siluf_(z3[0]), d[1] * r * g1.w * siluf_(z3[1])); *zp = o;
        }
    }
}

__device__ __forceinline__ unsigned sortable(float f) { unsigned u = __float_as_uint(f + 0.f); return (u & 0x80000000u) ? ~u : (u | 0x80000000u); }
__device__ __forceinline__ void p7_topk_naive(Ctx& C) {
    const int gw = C.bid * NWAVES + C.wave, NGW = C.G * NWAVES, lane = C.lane;
    LAS float* sc = (LAS float*)(C.lds + C.wave * 9216);
    LAS u32x4* qs = (LAS u32x4*)(C.lds + C.wave * 9216 + 8192);
    for (int m = gw; m < T; m += NGW) {
        const int t = m & (SEQ - 1), b = m >> 11, n = t + 1; int* sel = WSP(int, WS_SEL) + (size_t)m * 256;
        if (n <= 256) { for (int i = lane; i < 256; i += 64) sel[i] = i < n ? i : 0; continue; }
        qs[lane] = *(const u32x4*)(WSP(h16s, WS_QI) + (size_t)m * 1536 + 1024 + lane * 8);
        float wq[8];
#pragma unroll
        for (int hh = 0; hh < 8; ++hh) wq[hh] = WSP(float, WS_WIDX)[(size_t)m * 8 + hh];
        LDS_WAIT(); asm volatile("" ::: "memory");
        const int nj = (n + 63) >> 6;
        for (int jj = 0; jj < nj; ++jj) { const int s = jj * 64 + lane; const int sr = s < n ? s : t;
            const u32x4* kp = (const u32x4*)(WSP(h16s, WS_KIDX) + ((size_t)b * SEQ + sr) * 64); u32x4 kr[8];
#pragma unroll
            for (int i = 0; i < 8; ++i) kr[i] = kp[i];
            float score = 0.f;
#pragma unroll
            for (int hh = 0; hh < 8; ++hh) { float d = 0.f;
#pragma unroll
                for (int i = 0; i < 8; ++i) { const u32x4 qv = qs[hh * 8 + i];
                    const f32x2 k0 = unpkh(kr[i].x), k1 = unpkh(kr[i].y), k2 = unpkh(kr[i].z), k3 = unpkh(kr[i].w), q0 = unpkh(qv.x), q1 = unpkh(qv.y), q2 = unpkh(qv.z), q3 = unpkh(qv.w);
                    d += k0[0] * q0[0]; d += k0[1] * q0[1]; d += k1[0] * q1[0]; d += k1[1] * q1[1]; d += k2[0] * q2[0]; d += k2[1] * q2[1]; d += k3[0] * q3[0]; d += k3[1] * q3[1]; }
                score += wq[hh] * fmaxf(d, 0.f); }
            sc[s] = score; }
        LDS_WAIT(); asm volatile("" ::: "memory");
        unsigned key[32];
#pragma unroll
        for (int jj = 0; jj < 32; ++jj) { const int s = jj * 64 + lane; key[jj] = (s < n) ? sortable(sc[s]) : 0u; }
        unsigned prefix = 0u;
        for (int bit = 31; bit >= 0; --bit) { const unsigned cand = prefix | (1u << bit); int cnt = 0;
#pragma unroll
            for (int jj = 0; jj < 32; ++jj) cnt += __builtin_popcountll(__ballot(key[jj] >= cand));
            if (cnt >= 256) prefix = cand; }
        int ngt = 0;
#pragma unroll
        for (int jj = 0; jj < 32; ++jj) ngt += __builtin_popcountll(__ballot(key[jj] > prefix));
        int need = 256 - ngt, base = 0; const unsigned long long lt = (1ull << lane) - 1ull;
#pragma unroll
        for (int jj = 0; jj < 32; ++jj) { const bool gt = key[jj] > prefix; const bool eq = key[jj] == prefix;
            const unsigned long long meq = __ballot(eq); const int eqrank = __builtin_popcountll(meq & lt); const bool take = gt || (eq && eqrank < need);
            const unsigned long long mt = __ballot(take); if (take) sel[base + __builtin_popcountll(mt & lt)] = jj * 64 + lane;
            base += __builtin_popcountll(mt); const int ne = __builtin_popcountll(meq); need -= (ne < need ? ne : need); }
        LDS_WAIT(); asm volatile("" ::: "memory");
    }
}
__device__ __forceinline__ void p8_attn_naive(Ctx& C) {
    const int tid = C.tid;
    LAS float* qf = (LAS float*)C.lds;
    LAS float* ql = qf + 1024;
    LAS float* sp = ql + 4096;
    LAS float* ol = sp + 4096;
    LAS int* sl = (LAS int*)(ol + 4096);
    const float* wuk = C.in[6]; const float* wuv = C.in[7];
    for (int m = C.bid; m < T; m += C.G) {
        const int t = m & (SEQ - 1), b = m >> 11, cnt = t + 1 < 256 ? t + 1 : 256;
        { const unsigned w = *(const unsigned*)(WSP(h16s, WS_QI) + (size_t)m * 1536 + tid * 2); const f32x2 f = unpkh(w); qf[tid * 2] = f[0]; qf[tid * 2 + 1] = f[1]; }
        if (tid < 256) sl[tid] = WSP(int, WS_SEL)[(size_t)m * 256 + tid];
        __syncthreads();
        { const int h = tid >> 5, r0 = (tid & 31) * 8; f32x4 a0 = (f32x4){0.f, 0.f, 0.f, 0.f}, a1 = a0;
          for (int d = 0; d < 64; ++d) { const float qv = qf[h * 64 + d]; const float* wp = wuk + ((size_t)(h * 64 + d)) * 256 + r0; a0 += qv * *(const f32x4*)wp; a1 += qv * *(const f32x4*)(wp + 4); }
          *(LAS f32x4*)(ql + h * 256 + r0) = a0; *(LAS f32x4*)(ql + h * 256 + r0 + 4) = a1; }
        __syncthreads();
        { const int k = tid & 255, hg = tid >> 8; float acc[8];
#pragma unroll
          for (int i = 0; i < 8; ++i) acc[i] = 0.f;
          if (k < cnt) { const u32x4* kv = (const u32x4*)(WSP(h16s, WS_PQ) + ((size_t)b * SEQ + sl[k]) * 512 + 256);
            for (int rc = 0; rc < 32; ++rc) { const u32x4 w = kv[rc]; const f32x2 x0 = unpkh(w.x), x1 = unpkh(w.y), x2 = unpkh(w.z), x3 = unpkh(w.w);
#pragma unroll
                for (int i = 0; i < 8; ++i) { const LAS float* qp = ql + (hg * 8 + i) * 256 + rc * 8; const f32x4 q0 = *(const LAS f32x4*)qp, q1 = *(const LAS f32x4*)(qp + 4);
                    acc[i] += (x0[0] * q0.x + x0[1] * q0.y) + (x1[0] * q0.z + x1[1] * q0.w) + (x2[0] * q1.x + x2[1] * q1.y) + (x3[0] * q1.z + x3[1] * q1.w); } } }
#pragma unroll
          for (int i = 0; i < 8; ++i) sp[(hg * 8 + i) * 256 + k] = (k < cnt) ? acc[i] * 0.125f : -INFINITY; }
        __syncthreads();
        { const int lane = C.lane;
#pragma unroll
          for (int hh = 0; hh < 2; ++hh) { LAS float* row = sp + (C.wave * 2 + hh) * 256; float v[4]; float mx = -INFINITY;
#pragma unroll
            for (int i = 0; i < 4; ++i) { v[i] = row[i * 64 + lane]; mx = fmaxf(mx, v[i]); }
#pragma unroll
            for (int o = 1; o < 64; o <<= 1) mx = fmaxf(mx, __shfl_xor(mx, o));
            float sum = 0.f;
#pragma unroll
            for (int i = 0; i < 4; ++i) { v[i] = expf(v[i] - mx); sum += v[i]; }
            sum = wave_sum(sum); const float inv = 1.f / sum;
#pragma unroll
            for (int i = 0; i < 4; ++i) row[i * 64 + lane] = v[i] * inv; } }
        __syncthreads();
        { const int r = tid & 255, hg = tid >> 8; float acc[8];
#pragma unroll
          for (int i = 0; i < 8; ++i) acc[i] = 0.f;
          const h16s* kvb = WSP(h16s, WS_PQ) + (size_t)b * SEQ * 512 + 256 + r;
          for (int k = 0; k < cnt; ++k) { const float x = h2f(kvb[(size_t)sl[k] * 512]);
#pragma unroll
              for (int i = 0; i < 8; ++i) acc[i] += sp[(hg * 8 + i) * 256 + k] * x; }
#pragma unroll
          for (int i = 0; i < 8; ++i) ol[(hg * 8 + i) * 256 + r] = acc[i]; }
        __syncthreads();
        { const int h = tid >> 5, d0 = (tid & 31) * 2; float a0 = 0.f, a1 = 0.f;
          for (int r = 0; r < 256; ++r) { const float x = ol[h * 256 + r]; const f32x2 w = *(const f32x2*)(wuv + ((size_t)(h * 256 + r)) * 64 + d0); a0 += x * w.x; a1 += x * w.y; }
          *(unsigned*)(WSP(h16s, WS_OA) + (size_t)m * 1024 + h * 64 + d0) = pkh(a0, a1); }
        __syncthreads();
    }
}

__device__ __forceinline__ void p12_hn(Ctx& C) {
    const int gw = C.bid * NWAVES + C.wave, NGW = C.G * NWAVES;
    for (int m = gw; m < T; m += NGW) rms_row_f16(C.out + (size_t)m * DM, C.in[18], WSP(h16s, WS_PZ) + (size_t)m * DM, C.lane);
}
__device__ __forceinline__ void p15_final(Ctx& C) {
    const int gw = C.bid * NWAVES + C.wave, NGW = C.G * NWAVES, lane = C.lane;
    for (int m = gw; m < T; m += NGW) {
        f32x4* xr = (f32x4*)(C.out + (size_t)m * DM) + lane; const f32x4* gr = (const f32x4*)C.in[22] + lane;
        f32x4 v[4]; float s = 0.f;
#pragma unroll
        for (int j = 0; j < 4; ++j) { v[j] = xr[64 * j]; s += (v[j].x * v[j].x + v[j].y * v[j].y) + (v[j].z * v[j].z + v[j].w * v[j].w); }
        const float r = rsqrtf(wave_sum(s) * (1.f / 1024.f) + EPS);
#pragma unroll
        for (int j = 0; j < 4; ++j) { const f32x4 g = gr[64 * j]; xr[64 * j] = (f32x4){v[j].x * r * g.x, v[j].y * r * g.y, v[j].z * r * g.z, v[j].w * r * g.w}; }
    }
}

constexpr int N_PHASES = 16;
struct Args { const float* in[23]; float* out; unsigned char* ws; int ph_lo, ph_hi; };
__global__ void __launch_bounds__(NWAVES * 64, 2) mega_fwd(Args args) {
    extern __shared__ __attribute__((aligned(16))) unsigned char lds[];
    Ctx C;
    C.lds = (LAS unsigned char*)lds;
    C.tid = threadIdx.x; C.lane = C.tid & 63; C.wave = __builtin_amdgcn_readfirstlane(C.tid >> 6);
    C.G = gridDim.x; C.bid = blockIdx.x;
    C.in = args.in;
    C.out = args.out; C.ws = args.ws;
    volatile LAS unsigned* MISC = (volatile LAS unsigned*)(C.lds + MISC_OFF);
    for (int u = C.tid; u < (LDS_BYTES - RING_BYTES) / 4; u += NWAVES * 64) ((LAS unsigned*)(C.lds + RING_BYTES))[u] = 0u;
    __syncthreads();
    const int lo = args.ph_lo, hi = args.ph_hi;
    const bool multi = (hi - lo) > 1;
    XcdBarrier bar; bar.bar = (unsigned*)(C.ws + WS_CTL) + 4096; bar.x = 0; bar.st = nullptr;
    if (multi) bar = xcd_barrier_post((unsigned*)(C.ws + WS_CTL) + 4096, MISC + 8);
#define IN(k) (lo <= (k) && (k) < hi)
#define SEAM(k) do { if (IN(k) && IN((k) + 1)) xcd_barrier(bar); } while (0)
    typedef pg8::StaticOrder SO;
    if (IN(0)) { p0_prologue(C); } SEAM(0);
    if (IN(1)) { pg8::Gemm g{DOP(h16s, DO_H), DOP(h16s, DO_WIN), T, INWP, 1024, 1024, 1024}; SO S; S.init(T, INWP, C.G, C.bid);
        pg8::EpiProj E{WSP(h16s, WS_PQ), WSP(h16s, WS_PQKV), WSP(h16s, WS_PZ), WSP(h16s, WS_PG), WSP(float, WS_PS32)};
        pg8::gemm_phase<pg8::EpiProj, SO, true, true>(C.lds, g, S, E); } SEAM(1);
    if (IN(2)) { p2_prep(C); } SEAM(2);
    if (IN(3)) { p3_conv_inplace(C); } SEAM(3);
    if (IN(4)) { p4_scan_naive(C); } SEAM(4);
    if (IN(5)) { p5_gated_norm(C); } SEAM(5);
    if (IN(6)) { pg8::Gemm g{WSP(h16s, WS_PQ), WSP(h16s, WS_WQI), T, 1536, 256, 512, 256}; SO S; S.init(T, 1536, C.G, C.bid);
        pg8::EpiF16 E{WSP(h16s, WS_QI), 1536};
        pg8::gemm_phase<pg8::EpiF16, SO, true, true>(C.lds, g, S, E); } SEAM(6);
    if (IN(7)) { p7_topk_naive(C); } SEAM(7);
    if (IN(8)) { p8_attn_naive(C); } SEAM(8);
    if (IN(9)) { pg8::Gemm g{WSP(h16s, WS_OA), WSP(h16s, WS_WPA), T, 1024, 1024, 1024, 1024}; SO S; S.init(T, 1024, C.G, C.bid);
        pg8::EpiGateA E{WSP(h16s, WS_PG)};
        pg8::gemm_phase<pg8::EpiGateA, SO, true, true>(C.lds, g, S, E); } SEAM(9);
    if (IN(10)) { pg8::Gemm g{WSP(h16s, WS_PZ), WSP(h16s, WS_WPB), T, 1024, 1024, 1024, 1024}; SO S; S.init(T, 1024, C.G, C.bid);
        pg8::EpiMerge E{WSP(h16s, WS_PG)};
        pg8::gemm_phase<pg8::EpiMerge, SO, true, true>(C.lds, g, S, E); } SEAM(10);
    if (IN(11)) { pg8::Gemm g{WSP(h16s, WS_PG) + 1024, WSP(h16s, WS_WOUT), T, 1024, 1024, 2048, 1024}; SO S; S.init(T, 1024, C.G, C.bid);
        pg8::EpiRes E{C.in[0], C.out};
        pg8::gemm_phase<pg8::EpiRes, SO, true, true>(C.lds, g, S, E); } SEAM(11);
    if (IN(12)) { p12_hn(C); } SEAM(12);
    if (IN(13)) { pg8::Gemm g{WSP(h16s, WS_PZ), WSP(h16s, WS_WGU), T, 5632, 1024, 1024, 1024}; SO S; S.init(T, 5632, C.G, C.bid);
        pg8::EpiSwiglu E{WSP(h16s, WS_ACT)};
        pg8::gemm_phase<pg8::EpiSwiglu, SO, true, true>(C.lds, g, S, E); } SEAM(13);
    if (IN(14)) { pg8::Gemm g{WSP(h16s, WS_ACT), WSP(h16s, WS_WDN), T, 1024, 2816, 2816, 2816}; SO S; S.init(T, 1024, C.G, C.bid);
        pg8::EpiRes E{C.out, C.out};
        pg8::gemm_phase<pg8::EpiRes, SO, true, true>(C.lds, g, S, E); } SEAM(14);
    if (IN(15)) { p15_final(C); }
#undef IN
#undef SEAM
}

extern "C" void kernel_launch(void* const* d_in, const int* in_sizes, int n_in, void* d_out, int out_size, void* d_ws, size_t ws_size, hipStream_t stream) {
    static int grid = 0;
    if (grid == 0) {
        if (n_in != 23 || in_sizes[0] != T * DM || out_size != T * DM || ws_size < WS_END) { fprintf(stderr, "kernel_launch: unexpected shapes (n_in %d, in0 %d, out %d, ws %zu)\n", n_in, n_in > 0 ? in_sizes[0] : -1, out_size, ws_size); grid = -1; return; }
        int dev = 0, cus = 0, per_cu = 0;
        if (hipGetDevice(&dev) != hipSuccess || hipDeviceGetAttribute(&cus, hipDeviceAttributeMultiprocessorCount, dev) != hipSuccess) { grid = -1; return; }
        if (hipFuncSetAttribute((const void*)mega_fwd, hipFuncAttributeMaxDynamicSharedMemorySize, LDS_BYTES) != hipSuccess) { fprintf(stderr, "kernel_launch: hipFuncSetAttribute failed\n"); grid = -1; return; }
        if (hipOccupancyMaxActiveBlocksPerMultiprocessor(&per_cu, (const void*)mega_fwd, NWAVES * 64, LDS_BYTES) != hipSuccess || per_cu < 1) { fprintf(stderr, "kernel_launch: occupancy query says %d\n", per_cu); per_cu = 1; }
        (void)hipGetLastError();
        grid = cus;
    }
    if (grid < 0) return;
    (void)hipMemsetAsync((char*)d_ws + WS_CTL, 0, CTL_ZERO_BYTES, stream);
    Args a{};
    for (int i = 0; i < 23; ++i) a.in[i] = (const float*)d_in[i];
    a.out = (float*)d_out; a.ws = (unsigned char*)d_ws;
#ifdef MULTI_LAUNCH
    for (int p = 0; p < N_PHASES; ++p) { a.ph_lo = p; a.ph_hi = p + 1; hipLaunchKernelGGL(mega_fwd, dim3(grid), dim3(NWAVES * 64), LDS_BYTES, stream, a); }
#else
    a.ph_lo = 0; a.ph_hi = N_PHASES; hipLaunchKernelGGL(mega_fwd, dim3(grid), dim3(NWAVES * 64), LDS_BYTES, stream, a);
#endif
}
```

```cpp
#include <hip/hip_runtime.h>
#include <cstdio>
#include <cstdint>

#define GAS __attribute__((address_space(1)))
#define LAS __attribute__((address_space(3)))
typedef unsigned short h16s;
typedef _Float16 h16;
typedef h16 h16x8 __attribute__((ext_vector_type(8)));
typedef h16 h16x4 __attribute__((ext_vector_type(4)));
typedef h16 h16x2 __attribute__((ext_vector_type(2)));
typedef float f32x2 __attribute__((ext_vector_type(2)));
typedef float f32x4 __attribute__((ext_vector_type(4)));
typedef float f32x16 __attribute__((ext_vector_type(16)));
typedef unsigned u32x4 __attribute__((ext_vector_type(4)));
typedef unsigned u32x2 __attribute__((ext_vector_type(2)));

__device__ __forceinline__ unsigned pkh(float lo, float hi) { f32x2 v = {lo, hi}; h16x2 h = __builtin_convertvector(v, h16x2); return __builtin_bit_cast(unsigned, h); }
__device__ __forceinline__ f32x2 unpkh(unsigned u) { h16x2 h = __builtin_bit_cast(h16x2, u); return (f32x2){(float)h[0], (float)h[1]}; }
__device__ __forceinline__ float h2f(h16s s) { return (float)__builtin_bit_cast(h16, s); }
__device__ __forceinline__ h16s f2h(float f) { return __builtin_bit_cast(h16s, (h16)f); }
__device__ __forceinline__ float sigmoidf_(float x) { return __builtin_amdgcn_rcpf(1.f + __expf(-x)); }
__device__ __forceinline__ float siluf_(float x) { return x * __builtin_amdgcn_rcpf(1.f + __expf(-x)); }

namespace pg8 {
#define PG8_LAS __attribute__((address_space(3)))
typedef unsigned short bf16_t;
constexpr int BM = 256, BK = 64, HALF = 128, HTB = HALF * BK * 2  , STAGE_BYTES = 8 * HTB, NXCD = 8, WGM = 8;

__host__ __device__ __forceinline__ int lds_byte(int r, int c) { const int st = (r >> 4) * 2 + (c >> 5), rr = r & 15, cc = c & 31, ob = rr * 64 + cc * 2; return st * 1024 + (ob ^ (((ob >> 9) & 1) << 5)); }
__host__ __device__ __forceinline__ void stage_rc(int b, int& R, int& C) { const int st = b / 1024, sb = b % 1024, swz = sb ^ (((sb >> 9) & 1) << 5); R = (st >> 1) * 16 + swz / 64; C = (st & 1) * 32 + (swz % 64) / 2; }
__host__ __device__ __forceinline__ int perm32(int rho) { const int n = rho >> 4, i = rho & 15; return 8 * (i >> 2) + 4 * n + (i & 3); }

struct Unit { int pm, pn; };
struct Gemm { const bf16_t* A; const bf16_t* Bt; int M, N, K, lda, ldb; };

struct StaticOrder {
    int nM, nN, nwg, G, c;
    __host__ __device__ void init(int M, int N, int G_, int c_) { nM = M / BM; nN = N / BM; nwg = nM * nN; G = G_; c = c_; }
    __host__ __device__ bool next(int i, Unit& u) const {
        const long L = (long)i * G + c; if (L >= nwg) return false;
        int wgid = (int)L; { const int q = nwg / NXCD, r = nwg % NXCD, xcd = wgid % NXCD, off = wgid / NXCD; wgid = (xcd < r ? xcd * (q + 1) : r * (q + 1) + (xcd - r) * q) + off; }
        const int nig = WGM * nN, gid = wgid / nig, fm = gid * WGM, gsz = (nM - fm) < WGM ? (nM - fm) : WGM;
        u.pm = fm + ((wgid % nig) % gsz); u.pn = (wgid % nig) / gsz; return true;
    }
    __device__ __forceinline__ void a_ready(const Unit&) const {}
    __device__ __forceinline__ void done(const Unit&) const {}
};

__device__ __forceinline__ u32x4 pack8(const f32x4& a, const f32x4& b) { u32x4 w; w.x = pkh(a[0], a[1]); w.y = pkh(a[2], a[3]); w.z = pkh(b[0], b[1]); w.w = pkh(b[2], b[3]); return w; }

struct EpiF16 {
    static constexpr bool PERM = true, AFTER_DRAIN = false;
    bf16_t* O; int ldc;
    __device__ __forceinline__ void operator()(const f32x4 (&acc)[2][2][4][2], const Unit& u, int wr, int wc, int fr, int fq) const {
        const int row0 = u.pm * BM + wr * 64 + fr, col0 = u.pn * BM + wc * 32 + 8 * fq;
#pragma unroll
        for (int ai = 0; ai < 2; ++ai)
#pragma unroll
            for (int m = 0; m < 4; ++m) { bf16_t* rowp = O + (size_t)(row0 + ai * HALF + m * 16) * ldc + col0;
#pragma unroll
                for (int bj = 0; bj < 2; ++bj) *(u32x4*)(rowp + bj * HALF) = pack8(acc[ai][bj][m][0], acc[ai][bj][m][1]); }
    }
};
struct EpiProj {
    static constexpr bool PERM = true, AFTER_DRAIN = false;
    bf16_t *PQ, *PQKV, *PZ, *PG; float* PS32;
    __device__ __forceinline__ void operator()(const f32x4 (&acc)[2][2][4][2], const Unit& u, int wr, int wc, int fr, int fq) const {
        const int row0 = u.pm * BM + wr * 64 + fr, cw = wc * 32 + 8 * fq;
        if (u.pn == 26) {
#pragma unroll
            for (int ai = 0; ai < 2; ++ai)
#pragma unroll
                for (int m = 0; m < 4; ++m) { float* rowp = PS32 + (size_t)(row0 + ai * HALF + m * 16) * 256 + cw;
#pragma unroll
                    for (int bj = 0; bj < 2; ++bj) { *(f32x4*)(rowp + bj * HALF) = acc[ai][bj][m][0]; *(f32x4*)(rowp + bj * HALF + 4) = acc[ai][bj][m][1]; } }
        } else {
            bf16_t* base; int ldc, c0;
            if (u.pn < 2) { base = PQ; ldc = 512; c0 = u.pn * 256; } else if (u.pn < 14) { base = PQKV; ldc = 3072; c0 = (u.pn - 2) * 256; }
            else if (u.pn < 18) { base = PZ; ldc = 1024; c0 = (u.pn - 14) * 256; } else { base = PG; ldc = 2048; c0 = (u.pn - 18) * 256; }
#pragma unroll
            for (int ai = 0; ai < 2; ++ai)
#pragma unroll
                for (int m = 0; m < 4; ++m) { bf16_t* rowp = base + (size_t)(row0 + ai * HALF + m * 16) * ldc + c0 + cw;
#pragma unroll
                    for (int bj = 0; bj < 2; ++bj) *(u32x4*)(rowp + bj * HALF) = pack8(acc[ai][bj][m][0], acc[ai][bj][m][1]); }
        }
    }
};
struct EpiGateA {
    static constexpr bool PERM = true, AFTER_DRAIN = false;
    bf16_t* PG;
    __device__ __forceinline__ void operator()(const f32x4 (&acc)[2][2][4][2], const Unit& u, int wr, int wc, int fr, int fq) const {
        const int row0 = u.pm * BM + wr * 64 + fr, col0 = u.pn * BM + wc * 32 + 8 * fq;
#pragma unroll
        for (int ai = 0; ai < 2; ++ai)
#pragma unroll
            for (int m = 0; m < 4; ++m) { bf16_t* rowp = PG + (size_t)(row0 + ai * HALF + m * 16) * 2048 + col0;
#pragma unroll
                for (int bj = 0; bj < 2; ++bj) { const u32x4 g = *(const u32x4*)(rowp + bj * HALF); f32x4 o0, o1;
                    const f32x2 g0 = unpkh(g.x), g1 = unpkh(g.y), g2 = unpkh(g.z), g3 = unpkh(g.w);
                    o0[0] = sigmoidf_(g0[0]) * acc[ai][bj][m][0][0]; o0[1] = sigmoidf_(g0[1]) * acc[ai][bj][m][0][1]; o0[2] = sigmoidf_(g1[0]) * acc[ai][bj][m][0][2]; o0[3] = sigmoidf_(g1[1]) * acc[ai][bj][m][0][3];
                    o1[0] = sigmoidf_(g2[0]) * acc[ai][bj][m][1][0]; o1[1] = sigmoidf_(g2[1]) * acc[ai][bj][m][1][1]; o1[2] = sigmoidf_(g3[0]) * acc[ai][bj][m][1][2]; o1[3] = sigmoidf_(g3[1]) * acc[ai][bj][m][1][3];
                    *(u32x4*)(rowp + bj * HALF) = pack8(o0, o1); } }
    }
};
struct EpiMerge {
    static constexpr bool PERM = true, AFTER_DRAIN = false;
    bf16_t* PG;
    __device__ __forceinline__ void operator()(const f32x4 (&acc)[2][2][4][2], const Unit& u, int wr, int wc, int fr, int fq) const {
        const int row0 = u.pm * BM + wr * 64 + fr, col0 = u.pn * BM + wc * 32 + 8 * fq;
#pragma unroll
        for (int ai = 0; ai < 2; ++ai)
#pragma unroll
            for (int m = 0; m < 4; ++m) { bf16_t* rowp = PG + (size_t)(row0 + ai * HALF + m * 16) * 2048 + col0;
#pragma unroll
                for (int bj = 0; bj < 2; ++bj) { const u32x4 t = *(const u32x4*)(rowp + bj * HALF); const u32x4 g = *(const u32x4*)(rowp + 1024 + bj * HALF); f32x4 o0, o1;
                    const f32x2 g0 = unpkh(g.x), g1 = unpkh(g.y), g2 = unpkh(g.z), g3 = unpkh(g.w), t0 = unpkh(t.x), t1 = unpkh(t.y), t2 = unpkh(t.z), t3 = unpkh(t.w);
                    o0[0] = t0[0] + sigmoidf_(g0[0]) * acc[ai][bj][m][0][0]; o0[1] = t0[1] + sigmoidf_(g0[1]) * acc[ai][bj][m][0][1]; o0[2] = t1[0] + sigmoidf_(g1[0]) * acc[ai][bj][m][0][2]; o0[3] = t1[1] + sigmoidf_(g1[1]) * acc[ai][bj][m][0][3];
                    o1[0] = t2[0] + sigmoidf_(g2[0]) * acc[ai][bj][m][1][0]; o1[1] = t2[1] + sigmoidf_(g2[1]) * acc[ai][bj][m][1][1]; o1[2] = t3[0] + sigmoidf_(g3[0]) * acc[ai][bj][m][1][2]; o1[3] = t3[1] + sigmoidf_(g3[1]) * acc[ai][bj][m][1][3];
                    *(u32x4*)(rowp + 1024 + bj * HALF) = pack8(o0, o1); } }
    }
};
struct EpiRes {
    static constexpr bool PERM = false, AFTER_DRAIN = false;
    const float* base; float* out;
    __device__ __forceinline__ void operator()(const f32x4 (&acc)[2][2][4][2], const Unit& u, int wr, int wc, int fr, int fq) const {
        const int row0 = u.pm * BM + wr * 64 + fr, col0 = u.pn * BM + wc * 32 + 4 * fq;
#pragma unroll
        for (int ai = 0; ai < 2; ++ai)
#pragma unroll
            for (int m = 0; m < 4; ++m) { const size_t off = (size_t)(row0 + ai * HALF + m * 16) * 1024 + col0;
#pragma unroll
                for (int bj = 0; bj < 2; ++bj)
#pragma unroll
                    for (int n = 0; n < 2; ++n) { const f32x4 b = *(const f32x4*)(base + off + bj * HALF + n * 16); *(f32x4*)(out + off + bj * HALF + n * 16) = b + acc[ai][bj][m][n]; } }
    }
};
struct EpiSwiglu {
    static constexpr bool PERM = true, AFTER_DRAIN = false;
    bf16_t* ACT;
    __device__ __forceinline__ void operator()(const f32x4 (&acc)[2][2][4][2], const Unit& u, int wr, int wc, int fr, int fq) const {
        const int row0 = u.pm * BM + wr * 64 + fr, col0 = u.pn * HALF + wc * 32 + 8 * fq;
#pragma unroll
        for (int ai = 0; ai < 2; ++ai)
#pragma unroll
            for (int m = 0; m < 4; ++m) { f32x4 o0, o1;
#pragma unroll
                for (int e = 0; e < 4; ++e) { o0[e] = siluf_(acc[ai][0][m][0][e]) * acc[ai][1][m][0][e]; o1[e] = siluf_(acc[ai][0][m][1][e]) * acc[ai][1][m][1][e]; }
                *(u32x4*)(ACT + (size_t)(row0 + ai * HALF + m * 16) * 2816 + col0) = pack8(o0, o1); }
    }
};

template <class Epi, class Sched, bool ALIGN_EPI = false, bool SP2 = false>
__device__ __forceinline__ void gemm_phase(PG8_LAS unsigned char* lds, const Gemm g, const Sched& S, const Epi& E) {
    const int tid = threadIdx.x, wid = __builtin_amdgcn_readfirstlane(tid >> 6), lane = tid & 63, wr = wid >> 2, wc = wid & 3, fr = lane & 15, fq = lane >> 4;
    int K = g.K; asm volatile("" : "+s"(K));
    const int nt = K / BK;
    unsigned voffA[2], voffB[2];
#pragma unroll
    for (int i = 0; i < 2; ++i) { int R, C; stage_rc(tid * 16 + i * 8192, R, C); const int Rb = Epi::PERM ? ((R & ~31) + perm32(R & 31)) : R;
        voffA[i] = (unsigned)(R * g.lda + C) * 2u; voffB[i] = (unsigned)(Rb * g.ldb + C) * 2u; }
    const size_t kstep = (size_t)(BK * 2);
    const size_t hstepA = (size_t)HALF * g.lda * 2, hstepB = (size_t)HALF * g.ldb * 2;
    const size_t tstepA = 2 * hstepA, tstepB = 2 * hstepB;
    const unsigned ldsw = (unsigned)wid * 1024u;
    const int aoff = lds_byte(wr * 64 + fr, fq * 8), boff = lds_byte(wc * 32 + fr, fq * 8);
#define PG8_SA(b, h) (((b) * 2 + (h)) * HTB)
#define PG8_SB(b, h) ((4 + (b) * 2 + (h)) * HTB)
#define PG8_STAGE(bufoff, gbase, voff) do { _Pragma("unroll") for (int _i = 0; _i < 2; ++_i) \
        __builtin_amdgcn_global_load_lds((const unsigned*)((const char*)(gbase) + (voff)[_i]), (PG8_LAS unsigned*)(lds + (bufoff) + ldsw + _i * 8192), 16, 0, 0); } while (0)
#define PG8_LDA(dst, b, h) do { _Pragma("unroll") for (int m = 0; m < 4; ++m) _Pragma("unroll") for (int k = 0; k < 2; ++k) dst[m][k] = *(const PG8_LAS h16x8*)(lds + PG8_SA(b, h) + aoff + m * 2048 + k * 1024); } while (0)
#define PG8_LDB(dst, b, h) do { _Pragma("unroll") for (int n = 0; n < 2; ++n) _Pragma("unroll") for (int k = 0; k < 2; ++k) dst[n][k] = *(const PG8_LAS h16x8*)(lds + PG8_SB(b, h) + boff + n * 2048 + k * 1024); } while (0)
#define PG8_MMA(ai, bj, At, Bt) do { __builtin_amdgcn_s_setprio(1); _Pragma("unroll") for (int m = 0; m < 4; ++m) _Pragma("unroll") for (int n = 0; n < 2; ++n) _Pragma("unroll") for (int k = 0; k < 2; ++k) \
        acc[ai][bj][m][n] = __builtin_amdgcn_mfma_f32_16x16x32_f16(Bt[n][k], At[m][k], acc[ai][bj][m][n], 0, 0, 0); __builtin_amdgcn_s_setprio(0); } while (0)
#define PG8_WAIT_V(n) asm volatile("s_waitcnt vmcnt(" #n ")" ::: "memory")
#define PG8_WAIT_L(n) asm volatile("s_waitcnt lgkmcnt(" #n ")" ::: "memory")
#define PG8_BAR __builtin_amdgcn_s_barrier()
#define PG8_SCHED __builtin_amdgcn_sched_barrier(0)
    Unit cur, nxt; int ui = 0;
    if (!S.next(0, cur)) return;
    f32x4 acc[2][2][4][2];
#pragma unroll
    for (int a = 0; a < 2; ++a)
#pragma unroll
        for (int b = 0; b < 2; ++b)
#pragma unroll
            for (int m = 0; m < 4; ++m)
#pragma unroll
                for (int n = 0; n < 2; ++n) acc[a][b][m][n] = (f32x4){0.f, 0.f, 0.f, 0.f};
    h16x8 At[4][2], B0[2][2], B1[2][2];
    const char* cA = (const char*)g.A + (size_t)cur.pm * tstepA; const char* cB = (const char*)g.Bt + (size_t)cur.pn * tstepB;
    S.a_ready(cur);
    if constexpr (SP2) {
        PG8_STAGE(PG8_SB(0, 0), cB, voffB); PG8_STAGE(PG8_SB(0, 1), cB + hstepB, voffB); PG8_STAGE(PG8_SA(0, 0), cA, voffA); PG8_STAGE(PG8_SA(0, 1), cA + hstepA, voffA);
        if (wr == 1) PG8_BAR;
        PG8_WAIT_V(2); PG8_BAR;
        PG8_STAGE(PG8_SB(1, 0), cB + kstep, voffB); PG8_STAGE(PG8_SA(1, 0), cA + kstep, voffA); PG8_STAGE(PG8_SB(1, 1), cB + hstepB + kstep, voffB);
        PG8_WAIT_V(6); PG8_BAR;
    } else {
        PG8_STAGE(PG8_SB(0, 0), cB, voffB); PG8_STAGE(PG8_SA(0, 0), cA, voffA); PG8_STAGE(PG8_SB(0, 1), cB + hstepB, voffB); PG8_STAGE(PG8_SA(0, 1), cA + hstepA, voffA);
        if (wr == 1) PG8_BAR;
        PG8_WAIT_V(4); PG8_BAR;
        PG8_STAGE(PG8_SB(1, 0), cB + kstep, voffB); PG8_STAGE(PG8_SA(1, 0), cA + kstep, voffA); PG8_STAGE(PG8_SB(1, 1), cB + hstepB + kstep, voffB);
        PG8_WAIT_V(6); PG8_BAR;
    }
    for (;;) {
        const bool has_next = S.next(ui + 1, nxt);
        const char* nA = has_next ? (const char*)g.A + (size_t)nxt.pm * tstepA : cA; const char* nB = has_next ? (const char*)g.Bt + (size_t)nxt.pn * tstepB : cB;
        for (int t = 0; t < nt; t += 2) {
            const bool last = (t == nt - 2);
            const char* a1 = cA + (size_t)(t + 1) * kstep;
            const char* a2 = last ? nA : cA + (size_t)(t + 2) * kstep; const char* b2 = last ? nB : cB + (size_t)(t + 2) * kstep;
            const char* a3 = a2 + kstep; const char* b3 = b2 + kstep;
            if (last && has_next) S.a_ready(nxt);
            if constexpr (SP2) {
            PG8_LDB(B0, 0, 0); PG8_LDB(B1, 0, 1); PG8_SCHED; PG8_LDA(At, 0, 0); PG8_STAGE(PG8_SA(1, 1), a1 + hstepA, voffA);
            PG8_WAIT_V(8); PG8_WAIT_L(0); PG8_BAR; PG8_MMA(0, 0, At, B0); PG8_MMA(0, 1, At, B1); PG8_BAR; PG8_SCHED;
            PG8_LDA(At, 0, 1); PG8_STAGE(PG8_SB(0, 0), b2, voffB); PG8_STAGE(PG8_SB(0, 1), b2 + hstepB, voffB); PG8_STAGE(PG8_SA(0, 0), a2, voffA);
            PG8_WAIT_V(8); PG8_WAIT_L(0); PG8_BAR; PG8_MMA(1, 0, At, B0); PG8_MMA(1, 1, At, B1); PG8_BAR; PG8_SCHED;
            PG8_LDB(B0, 1, 0); PG8_LDB(B1, 1, 1); PG8_SCHED; PG8_LDA(At, 1, 0); PG8_STAGE(PG8_SA(0, 1), a2 + hstepA, voffA);
            PG8_WAIT_V(8); PG8_WAIT_L(0); PG8_BAR; PG8_MMA(0, 0, At, B0); PG8_MMA(0, 1, At, B1); PG8_BAR; PG8_SCHED;
            PG8_LDA(At, 1, 1); PG8_STAGE(PG8_SB(1, 0), b3, voffB); PG8_STAGE(PG8_SB(1, 1), b3 + hstepB, voffB); PG8_STAGE(PG8_SA(1, 0), a3, voffA);
            PG8_WAIT_V(8); PG8_WAIT_L(0); PG8_BAR; PG8_MMA(1, 0, At, B0); PG8_MMA(1, 1, At, B1); PG8_BAR; PG8_SCHED;
            } else {
            PG8_LDB(B0, 0, 0); PG8_SCHED; PG8_LDA(At, 0, 0); PG8_STAGE(PG8_SA(1, 1), a1 + hstepA, voffA);
            PG8_WAIT_L(8); PG8_BAR; PG8_WAIT_L(0); PG8_MMA(0, 0, At, B0); PG8_BAR; PG8_SCHED;
            PG8_LDB(B1, 0, 1); PG8_STAGE(PG8_SB(0, 0), b2, voffB);
            PG8_BAR; PG8_WAIT_L(0); PG8_MMA(0, 1, At, B1); PG8_BAR;
            PG8_LDA(At, 0, 1); PG8_STAGE(PG8_SA(0, 0), a2, voffA);
            PG8_BAR; PG8_WAIT_L(0); PG8_MMA(1, 0, At, B0); PG8_BAR; PG8_SCHED;
            PG8_STAGE(PG8_SB(0, 1), b2 + hstepB, voffB);
            PG8_WAIT_V(6); PG8_BAR; PG8_MMA(1, 1, At, B1); PG8_BAR;
            PG8_LDB(B0, 1, 0); PG8_SCHED; PG8_LDA(At, 1, 0); PG8_STAGE(PG8_SA(0, 1), a2 + hstepA, voffA);
            PG8_WAIT_L(8); PG8_BAR; PG8_WAIT_L(0); PG8_MMA(0, 0, At, B0); PG8_BAR; PG8_SCHED;
            PG8_LDB(B1, 1, 1); PG8_STAGE(PG8_SB(1, 0), b3, voffB);
            PG8_BAR; PG8_WAIT_L(0); PG8_MMA(0, 1, At, B1); PG8_BAR;
            PG8_LDA(At, 1, 1); PG8_STAGE(PG8_SA(1, 0), a3, voffA);
            PG8_BAR; PG8_WAIT_L(0); PG8_MMA(1, 0, At, B0); PG8_BAR; PG8_SCHED;
            PG8_STAGE(PG8_SB(1, 1), b3 + hstepB, voffB);
            PG8_WAIT_V(6); PG8_BAR; PG8_MMA(1, 1, At, B1); PG8_BAR;
            }
        }
        if constexpr (ALIGN_EPI) { if (wr == 0) PG8_BAR; }
        if constexpr (!Epi::AFTER_DRAIN) { E(acc, cur, wr, wc, fr, fq); S.done(cur); }
        if (!has_next) break;
#pragma unroll
        for (int a = 0; a < 2; ++a)
#pragma unroll
            for (int b = 0; b < 2; ++b)
#pragma unroll
                for (int m = 0; m < 4; ++m)
#pragma unroll
                    for (int n = 0; n < 2; ++n) acc[a][b][m][n] = (f32x4){0.f, 0.f, 0.f, 0.f};
        cur = nxt; cA = nA; cB = nB; ++ui;
        if constexpr (ALIGN_EPI) { if (wr == 1) PG8_BAR; }
    }
    PG8_WAIT_V(0);
    if constexpr (!ALIGN_EPI) { if (wr == 0) PG8_BAR; }
    PG8_BAR;
    if constexpr (Epi::AFTER_DRAIN) { E.fused(acc, cur, wr, wc, fr, fq, lds, wid, lane); S.done(cur); }
#undef PG8_SA
#undef PG8_SB
#undef PG8_STAGE
#undef PG8_LDA
#undef PG8_LDB
#undef PG8_MMA
#undef PG8_WAIT_V
#undef PG8_WAIT_L
#undef PG8_BAR
#undef PG8_SCHED
}
}
#define XB_TMO      128
#define XB_XCNT(j)  (256  + 64 * (j))
#define XB_XSUB(j)  (1280 + 64 * (j))
#define XB_XGEN(j)  (2304 + 64 * (j))
#define XB_TOP      3328
#define XB_TOPGEN   3392
#define XCD_BAR_WORDS 3456
#define XB_SPIN_CAP (1u << 23)

__device__ __forceinline__ unsigned xb_ld(unsigned* p)              { return __hip_atomic_load(p, __ATOMIC_RELAXED, __HIP_MEMORY_SCOPE_AGENT); }
__device__ __forceinline__ unsigned xb_add(unsigned* p, unsigned v) { return __hip_atomic_fetch_add(p, v, __ATOMIC_RELAXED, __HIP_MEMORY_SCOPE_AGENT); }
__device__ __forceinline__ unsigned xb_xcc_id() { return (unsigned)__builtin_amdgcn_s_getreg((3 << 11) | 20) & 0xFu; }
#define XB_SPIN(cond, bar) do { unsigned _sp = 0; while (cond) { __builtin_amdgcn_s_sleep(1); \
    if ((++_sp & 255u) == 0u) { if (xb_ld(&(bar)[XB_TMO])) break; if (_sp > XB_SPIN_CAP) { atomicAdd(&(bar)[XB_TMO], 1u); break; } } } } while (0)

struct XcdBarrier {
    unsigned* bar; unsigned x;
    volatile LAS unsigned* st;
};

__device__ __forceinline__ XcdBarrier xcd_barrier_post(unsigned* bar, volatile LAS unsigned* st) {
    XcdBarrier b; b.bar = bar; b.x = xb_xcc_id(); b.st = st;
    if (threadIdx.x == 0) (void)xb_add(&bar[XB_XCNT(b.x)], 1u);
    return b;
}
__device__ __forceinline__ void xcd_barrier_complete(unsigned* bar, unsigned x, unsigned& nloc, unsigned& nx) {
    const unsigned G = gridDim.x * gridDim.y * gridDim.z;
    unsigned sum, cnt, mine, sp = 0u;
    for (;;) {
        sum = 0u; cnt = 0u; mine = 0u;
#pragma unroll
        for (unsigned j = 0; j < 16; ++j) { const unsigned c = xb_ld(&bar[XB_XCNT(j)]); sum += c; cnt += (c > 0u) ? 1u : 0u; mine = (j == x) ? c : mine; }
        if (sum == G) break;
        __builtin_amdgcn_s_sleep(1);
        if ((++sp & 255u) == 0u) { if (xb_ld(&bar[XB_TMO])) break; if (sp > XB_SPIN_CAP) { atomicAdd(&bar[XB_TMO], 1u); break; } }
    }
    nloc = mine > 0u ? mine : 1u; nx = cnt > 0u ? cnt : 1u;
}

__device__ __forceinline__ void xcd_barrier(const XcdBarrier& b) {
    asm volatile("s_waitcnt vmcnt(0)" ::: "memory");
    __syncthreads();
    if (threadIdx.x == 0) {
        unsigned* bar = b.bar;
        __builtin_amdgcn_s_waitcnt(0);
        unsigned nloc = b.st[0], nx = b.st[1];
        if (nloc == 0u) { xcd_barrier_complete(bar, b.x, nloc, nx); b.st[0] = nloc; b.st[1] = nx; }
        const unsigned old = xb_add(&bar[XB_XSUB(b.x)], 1u);
        const unsigned gen = old / nloc;
        if (old + 1u == (gen + 1u) * nloc) {
            __builtin_amdgcn_fence(__ATOMIC_RELEASE, "agent");
            asm volatile("s_waitcnt vmcnt(0)" ::: "memory");
            const unsigned og = xb_add(&bar[XB_TOP], 1u);
            const unsigned tg = og / nx;
            if (og + 1u == (tg + 1u) * nx) xb_add(&bar[XB_TOPGEN], 1u);
            else XB_SPIN(xb_ld(&bar[XB_TOPGEN]) == tg, bar);
            __builtin_amdgcn_fence(__ATOMIC_ACQUIRE, "agent");
            xb_add(&bar[XB_XGEN(b.x)], 1u);
            asm volatile("s_waitcnt vmcnt(0)" ::: "memory");
        } else {
            XB_SPIN(xb_ld(&bar[XB_XGEN(b.x)]) == gen, bar);
            __builtin_amdgcn_fence(__ATOMIC_ACQUIRE, "agent");
            asm volatile("s_waitcnt vmcnt(0)" ::: "memory");
        }
    }
    __syncthreads();
}

constexpr int NWAVES = 8;
constexpr int T = 16384, SEQ = 2048, NBATCH = 8, DM = 1024, DFF = 2816, INW = 6744, INWP = 6912;
constexpr float EPS = 1e-6f;
constexpr size_t MiB = 1u << 20;
constexpr size_t WS_CTL = 0, CTL_ZERO_BYTES = 1 * MiB;
constexpr size_t WS_WGU = 1 * MiB;
constexpr size_t WS_WDN = 12 * MiB;
constexpr size_t WS_WPA = WS_WDN + 5632 * 1024;
constexpr size_t WS_WPB = WS_WPA + 2 * MiB;
constexpr size_t WS_WOUT = WS_WPB + 2 * MiB;
constexpr size_t WS_WQI = WS_WOUT + 2 * MiB;
constexpr size_t WS_WUKT = WS_WQI + 768 * 1024;
constexpr size_t WS_WUVT = WS_WUKT + 512 * 1024;
constexpr size_t WS_KIDX = 25 * MiB + 256 * 1024;
constexpr size_t WS_WIDX = WS_KIDX + 2 * MiB;
constexpr size_t WS_BETA = WS_WIDX + 512 * 1024;
constexpr size_t WS_GG = WS_BETA + 512 * 1024;
constexpr size_t WS_PQ = 29 * MiB;
constexpr size_t WS_PQKV = 45 * MiB;
constexpr size_t WS_PZ = 141 * MiB;
constexpr size_t WS_PG = 173 * MiB;
constexpr size_t WS_PS32 = 237 * MiB;
constexpr size_t WS_END = 253 * MiB;
constexpr size_t WS_QI = WS_PQKV;
constexpr size_t WS_SEL = WS_QI + 48 * MiB;
constexpr size_t WS_OA = WS_SEL + 16 * MiB;
constexpr size_t WS_ACT = WS_PQKV;
constexpr size_t DO_H = 0;
constexpr size_t DO_WIN = 32 * MiB;
constexpr size_t DO_HALO = 0;

constexpr int LDS_BYTES = 147456;
constexpr int RING_BYTES = 139264;
constexpr int MISC_OFF = RING_BYTES + 320;

#define LDS_WAIT() asm volatile("s_waitcnt lgkmcnt(0)" ::: "memory")
#define VM_WAIT() asm volatile("s_waitcnt vmcnt(0)" ::: "memory")

__device__ __forceinline__ float wave_sum(float v) {
#pragma unroll
    for (int o = 1; o < 64; o <<= 1) v += __shfl_xor(v, o);
    return v;
}
__device__ __forceinline__ float half_sum(float v) {
#pragma unroll
    for (int o = 1; o < 32; o <<= 1) v += __shfl_xor(v, o);
    return v;
}

__device__ __forceinline__ int lane_id_asm() { int l; asm volatile("v_mbcnt_lo_u32_b32 %0, -1, 0\n\tv_mbcnt_hi_u32_b32 %0, -1, %0" : "=v"(l)); return l; }
struct Ctx {
    LAS unsigned char* lds;
    int tid, lane, wave, G, bid;
    const float* const* in; float* out; unsigned char* ws;
};
#define WSP(T_, off) ((T_*)(C.ws + (off)))
#define DOP(T_, off) ((T_*)((unsigned char*)C.out + (off)))

struct Src { const float* p; int ld; };
struct MapId { const float* W; int N; __device__ __forceinline__ Src operator()(int n) const { return Src{W + n, N}; } };
struct MapWin { const float* W; __device__ __forceinline__ Src operator()(int n) const {
    int c;
    if (n < 512) c = n; else if (n < 1536) c = 584 + (n - 512); else if (n < 2560) c = 1608 + (n - 1536); else if (n < 3584) c = 2632 + (n - 2560);
    else if (n < 4608) c = 3672 + (n - 3584); else if (n < 5632) c = 4696 + (n - 4608); else if (n < 6656) c = 5720 + (n - 5632);
    else { const int q = n - 6656; if (q < 64) c = 512 + q; else if (q < 72) c = 576 + (q - 64); else if (q < 80) c = 3656 + (q - 72); else if (q < 88) c = 3664 + (q - 80); else c = -1; }
    return Src{c >= 0 ? W + c : nullptr, INW}; } };
struct MapGU { const float* Wg; const float* Wu; __device__ __forceinline__ Src operator()(int n) const { const int t = n >> 8, w = n & 255; return (w < 128) ? Src{Wg + 128 * t + w, DFF} : Src{Wu + 128 * t + (w - 128), DFF}; } };
struct MapQI { const float* Wq; const float* Wi; __device__ __forceinline__ Src operator()(int n) const { return (n < 1024) ? Src{Wq + n, 1024} : Src{Wi + (n - 1024), 512}; } };

template <class Map>
__device__ __forceinline__ void tr_item(const Map& map, int K, h16s* WT, LAS float* scr, int item, int nblk, int lane) {
    const int kb = item / nblk, nb = item % nblk, k0 = 64 * kb, n0 = 32 * nb;
    const Src s = map(n0 + (lane & 31));
#pragma unroll 8
    for (int i = 0; i < 32; ++i) { const int kk = 2 * i + (lane >> 5); scr[kk * 33 + (lane & 31)] = s.p ? s.p[(size_t)(k0 + kk) * s.ld] : 0.f; }
    LDS_WAIT(); asm volatile("" ::: "memory");
    const int c = lane & 7;
#pragma unroll
    for (int j = 0; j < 4; ++j) { const int n = (lane >> 3) + 8 * j; const LAS float* q = scr + (8 * c) * 33 + n;
        u32x4 o; o.x = pkh(q[0 * 33], q[1 * 33]); o.y = pkh(q[2 * 33], q[3 * 33]); o.z = pkh(q[4 * 33], q[5 * 33]); o.w = pkh(q[6 * 33], q[7 * 33]);
        *(u32x4*)(WT + (size_t)(n0 + n) * K + k0 + 8 * c) = o; }
    LDS_WAIT(); asm volatile("" ::: "memory");
}
__device__ __forceinline__ void rms_row_f16(const float* xrow, const float* g, h16s* orow, int lane) {
    const f32x4* xr = (const f32x4*)xrow + lane; const f32x4* gr = (const f32x4*)g + lane;
    f32x4 v[4]; float s = 0.f;
#pragma unroll
    for (int j = 0; j < 4; ++j) { v[j] = xr[64 * j]; s += (v[j].x * v[j].x + v[j].y * v[j].y) + (v[j].z * v[j].z + v[j].w * v[j].w); }
    const float r = rsqrtf(wave_sum(s) * (1.f / 1024.f) + EPS);
    u32x2* o8 = (u32x2*)orow + lane;
#pragma unroll
    for (int j = 0; j < 4; ++j) { const f32x4 gg = gr[64 * j]; u32x2 w; w.x = pkh(v[j].x * r * gg.x, v[j].y * r * gg.y); w.y = pkh(v[j].z * r * gg.z, v[j].w * r * gg.w); o8[64 * j] = w; }
}
__device__ __forceinline__ void p0_prologue(Ctx& C) {
    LAS float* scr = (LAS float*)(C.lds + C.wave * 16384);
    const int gw = C.bid * NWAVES + C.wave, NGW = C.G * NWAVES;
    constexpr int I_IN = 16 * (INWP / 32), I_GU = 16 * (5632 / 32), I_DN = 44 * 32, I_SQ = 16 * 32, I_QI = 4 * 48;
    constexpr int I_UK = 16 * 8, I_UV = 16 * 8;
    constexpr int NITEMS = I_IN + I_GU + I_DN + 3 * I_SQ + I_QI + I_UK + I_UV;
    for (int it = gw; it < NITEMS; it += NGW) {
        int r = it;
        if (r < I_IN) { tr_item(MapWin{C.in[2]}, 1024, DOP(h16s, DO_WIN), scr, r, INWP / 32, C.lane); continue; } r -= I_IN;
        if (r < I_GU) { tr_item(MapGU{C.in[19], C.in[20]}, 1024, WSP(h16s, WS_WGU), scr, r, 5632 / 32, C.lane); continue; } r -= I_GU;
        if (r < I_DN) { tr_item(MapId{C.in[21], 1024}, 2816, WSP(h16s, WS_WDN), scr, r, 32, C.lane); continue; } r -= I_DN;
        if (r < I_SQ) { tr_item(MapId{C.in[11], 1024}, 1024, WSP(h16s, WS_WPA), scr, r, 32, C.lane); continue; } r -= I_SQ;
        if (r < I_SQ) { tr_item(MapId{C.in[16], 1024}, 1024, WSP(h16s, WS_WPB), scr, r, 32, C.lane); continue; } r -= I_SQ;
        if (r < I_SQ) { tr_item(MapId{C.in[17], 1024}, 1024, WSP(h16s, WS_WOUT), scr, r, 32, C.lane); continue; } r -= I_SQ;
        if (r < I_QI) { tr_item(MapQI{C.in[5], C.in[8]}, 256, WSP(h16s, WS_WQI), scr, r, 48, C.lane); continue; } r -= I_QI;
        if (r < I_UK) { const int h = r >> 3; tr_item(MapId{C.in[6] + (size_t)h * 64 * 256, 256}, 64, WSP(h16s, WS_WUKT) + (size_t)h * 256 * 64, scr, r & 7, 8, C.lane); continue; } r -= I_UK;
        { const int h = r >> 3; tr_item(MapId{C.in[7] + (size_t)h * 256 * 64, 64}, 256, WSP(h16s, WS_WUVT) + (size_t)h * 64 * 256, scr, r & 7, 2, C.lane); }
    }
    for (int m = gw; m < T; m += NGW) rms_row_f16(C.in[0] + (size_t)m * DM, C.in[1], DOP(h16s, DO_H) + (size_t)m * DM, C.lane);
}

__device__ __forceinline__ void p2_prep(Ctx& C) {
    const int gw = C.bid * NWAVES + C.wave, NGW = C.G * NWAVES, lane = C.lane;
    const float* cqg = C.in[3]; const float* ckvg = C.in[4]; const float* lng = C.in[9]; const float* lnb = C.in[10]; const float* alog = C.in[13]; const float* dtb = C.in[14];
    for (int m = gw; m < T; m += NGW) {
        { u32x4* p = WSP(u32x4, WS_PQ) + (size_t)m * 64 + lane; const u32x4 w = *p; const float* g = (lane < 32 ? cqg : ckvg) + (lane & 31) * 8;
          const f32x2 a = unpkh(w.x), b = unpkh(w.y), c = unpkh(w.z), d = unpkh(w.w);
          const float ss = half_sum((a[0] * a[0] + a[1] * a[1]) + (b[0] * b[0] + b[1] * b[1]) + (c[0] * c[0] + c[1] * c[1]) + (d[0] * d[0] + d[1] * d[1]));
          const float r = rsqrtf(ss * (1.f / 256.f) + EPS); const f32x4 g0 = *(const f32x4*)g, g1 = *(const f32x4*)(g + 4);
          u32x4 o; o.x = pkh(a[0] * r * g0.x, a[1] * r * g0.y); o.y = pkh(b[0] * r * g0.z, b[1] * r * g0.w); o.z = pkh(c[0] * r * g1.x, c[1] * r * g1.y); o.w = pkh(d[0] * r * g1.z, d[1] * r * g1.w); *p = o; }
        const float* ps = WSP(float, WS_PS32) + (size_t)m * 256;
        { const float x = ps[lane]; const float mu = wave_sum(x) * (1.f / 64.f); const float xc = x - mu; const float var = wave_sum(xc * xc) * (1.f / 64.f);
          const float y = xc * rsqrtf(var + EPS) * lng[lane] + lnb[lane]; WSP(h16s, WS_KIDX)[(size_t)m * 64 + lane] = f2h(y); }
        if (lane < 8) {
            WSP(float, WS_WIDX)[(size_t)m * 8 + lane] = ps[64 + lane] * (0.35355339059327373f * 0.125f);
            WSP(float, WS_BETA)[(size_t)m * 8 + lane] = 1.f / (1.f + expf(-ps[72 + lane]));
            const float xa = ps[80 + lane] + dtb[lane]; const float sp = xa > 20.f ? xa : log1pf(expf(xa));
            WSP(float, WS_GG)[(size_t)m * 8 + lane] = -expf(alog[lane]) * sp;
        }
        const int t = m & (SEQ - 1), tc = t & 63, c = t >> 6;
        if (tc >= 61 && c < 31) {
            const u32x4* src = WSP(u32x4, WS_PQKV) + (size_t)m * 384; u32x4* dst = DOP(u32x4, DO_HALO) + ((size_t)((m >> 11) * 32 + c + 1) * 3 + (tc - 61)) * 384;
#pragma unroll
            for (int i = 0; i < 6; ++i) dst[i * 64 + lane] = src[i * 64 + lane];
        }
    }
}

__device__ __forceinline__ void p3_conv_inplace(Ctx& C) {
    LAS float* tile = (LAS float*)C.lds;
    const float* convw = C.in[12];
    const int tid = C.tid;
    for (int u = C.bid; u < NBATCH * 32 * 8 * 3; u += C.G) {
        const int part = u % 3, h = (u / 3) & 7, c = (u / 24) & 31, b = u / (24 * 32);
        const size_t m0 = (size_t)b * SEQ + c * 64; const int colb = part * 1024 + h * 128;
        for (int i = tid; i < 67 * 16; i += 512) { const int row = i >> 4, ch = i & 15; u32x4 w = (u32x4){0u, 0u, 0u, 0u};
            if (row >= 3) w = *(const u32x4*)(WSP(h16s, WS_PQKV) + (m0 + row - 3) * 3072 + colb + ch * 8);
            else if (c > 0) w = *(const u32x4*)(DOP(h16s, DO_HALO) + ((size_t)(b * 32 + c) * 3 + row) * 3072 + colb + ch * 8);
            const f32x2 a = unpkh(w.x), bb = unpkh(w.y), cc = unpkh(w.z), d = unpkh(w.w); LAS float* tp = tile + row * 128 + ch * 8;
            *(LAS f32x4*)tp = (f32x4){a[0], a[1], bb[0], bb[1]}; *(LAS f32x4*)(tp + 4) = (f32x4){cc[0], cc[1], d[0], d[1]}; }
        __syncthreads();
        const int r = tid >> 3, cg = tid & 7; float o[16]; float ss = 0.f;
#pragma unroll
        for (int i = 0; i < 16; ++i) { const int col = cg * 16 + i; float a = 0.f;
#pragma unroll
            for (int j = 0; j < 4; ++j) a += convw[j * 3072 + colb + col] * tile[(r + j) * 128 + col];
            a = a / (1.f + expf(-a)); o[i] = a; ss += a * a; }
        if (part < 2) { ss += __shfl_xor(ss, 1); ss += __shfl_xor(ss, 2); ss += __shfl_xor(ss, 4);
            const float sc = rsqrtf(ss + EPS) * (part == 0 ? 0.08838834764831845f : 1.f);
#pragma unroll
            for (int i = 0; i < 16; ++i) o[i] *= sc; }
        u32x4 w0, w1; w0.x = pkh(o[0], o[1]); w0.y = pkh(o[2], o[3]); w0.z = pkh(o[4], o[5]); w0.w = pkh(o[6], o[7]); w1.x = pkh(o[8], o[9]); w1.y = pkh(o[10], o[11]); w1.z = pkh(o[12], o[13]); w1.w = pkh(o[14], o[15]);
        u32x4* dst = (u32x4*)(WSP(h16s, WS_PQKV) + (m0 + r) * 3072 + colb + cg * 16); dst[0] = w0; dst[1] = w1;
        __syncthreads();
    }
}
__device__ __forceinline__ void p4_scan_naive(Ctx& C) {
    if (C.wave != 0) return;
    const int lane = C.lane;
    LAS u32x4* kq = (LAS u32x4*)C.lds;
    for (int u = C.bid; u < 256; u += C.G) {
    const int bh = u >> 2, b = bh >> 3, h = bh & 7, j = (u & 3) * 32 + (lane & 31), dh = lane >> 5;
    float S[64];
#pragma unroll
    for (int d = 0; d < 64; ++d) S[d] = 0.f;
    h16s* base = WSP(h16s, WS_PQKV) + (size_t)b * SEQ * 3072;
    for (int t0 = 0; t0 < SEQ; t0 += 16) {
#pragma unroll
        for (int i = 0; i < 8; ++i) { const int idx = i * 64 + lane, row = idx >> 5, ch = idx & 31;
            kq[idx] = *(const u32x4*)(base + (size_t)(t0 + row) * 3072 + (ch < 16 ? h * 128 + ch * 8 : 1024 + h * 128 + (ch - 16) * 8)); }
        LDS_WAIT(); asm volatile("" ::: "memory");
#pragma unroll 1
        for (int tt = 0; tt < 16; ++tt) {
            const size_t m = (size_t)b * SEQ + t0 + tt; h16s* vp = base + (size_t)(t0 + tt) * 3072 + 2048 + h * 128 + j;
            const float v = h2f(*vp), beta = WSP(float, WS_BETA)[m * 8 + h], a = expf(WSP(float, WS_GG)[m * 8 + h]);
            float dot = 0.f;
#pragma unroll
            for (int c = 0; c < 8; ++c) { const h16x8 kv = __builtin_bit_cast(h16x8, kq[tt * 32 + 16 + dh * 8 + c]);
#pragma unroll
                for (int e = 0; e < 8; ++e) dot += S[c * 8 + e] * (float)kv[e]; }
            dot += __shfl_xor(dot, 32);
            const float uu = beta * (v - a * dot); float o = 0.f;
#pragma unroll
            for (int c = 0; c < 8; ++c) { const h16x8 kv = __builtin_bit_cast(h16x8, kq[tt * 32 + 16 + dh * 8 + c]); const h16x8 qv = __builtin_bit_cast(h16x8, kq[tt * 32 + dh * 8 + c]);
#pragma unroll
                for (int e = 0; e < 8; ++e) { const float s = a * S[c * 8 + e] + (float)kv[e] * uu; S[c * 8 + e] = s; o += s * (float)qv[e]; } }
            o += __shfl_xor(o, 32);
            if (dh == 0) *vp = f2h(o);
        }
        asm volatile("" ::: "memory");
    }
    }
}
__device__ __forceinline__ void p5_gated_norm(Ctx& C) {
    const int gw = C.bid * NWAVES + C.wave, NGW = C.G * NWAVES, lane = C.lane; const float* og = C.in[15];
    for (int m = gw; m < T; m += NGW) {
#pragma unroll
        for (int p = 0; p < 2; ++p) {
            const int col = p * 512 + lane * 8;
            const u32x4 w = *(const u32x4*)(WSP(h16s, WS_PQKV) + (size_t)m * 3072 + 2048 + col); u32x4* zp = (u32x4*)(WSP(h16s, WS_PZ) + (size_t)m * 1024 + col); const u32x4 z = *zp;
            const f32x2 a = unpkh(w.x), b = unpkh(w.y), c = unpkh(w.z), d = unpkh(w.w);
            float ss = (a[0] * a[0] + a[1] * a[1]) + (b[0] * b[0] + b[1] * b[1]) + (c[0] * c[0] + c[1] * c[1]) + (d[0] * d[0] + d[1] * d[1]);
            ss += __shfl_xor(ss, 1); ss += __shfl_xor(ss, 2); ss += __shfl_xor(ss, 4); ss += __shfl_xor(ss, 8);
            const float r = rsqrtf(ss * (1.f / 128.f) + EPS); const float* g = og + (col & 127); const f32x4 g0 = *(const f32x4*)g, g1 = *(const f32x4*)(g + 4);
            const f32x2 z0 = unpkh(z.x), z1 = unpkh(z.y), z2 = unpkh(z.z), z3 = unpkh(z.w);
            u32x4 o; o.x = pkh(a[0] * r * g0.x * siluf_(z0[0]), a[1] * r * g0.y * siluf_(z0[1])); o.y = pkh(b[0] * r * g0.z * siluf_(z1[0]), b[1] * r * g0.w * siluf_(z1[1]));
            o.z = pkh(c[0] * r * g1.x * siluf_(z2[0]), c[1] * r * g1.y * siluf_(z2[1])); o.w = pkh(d[0] * r * g1.z * siluf_(z3[0]), d[1] * r * g1.w * siluf_(z3[1])); *zp = o;
        }
    }
}

__device__ __forceinline__ unsigned sortable(float f) { unsigned u = __float_as_uint(f + 0.f); return (u & 0x80000000u) ? ~u : (u | 0x80000000u); }
__device__ __forceinline__ void p7_topk_naive(Ctx& C) {
    const int gw = C.bid * NWAVES + C.wave, NGW = C.G * NWAVES, lane = C.lane;
    LAS float* sc = (LAS float*)(C.lds + C.wave * 9216);
    LAS u32x4* qs = (LAS u32x4*)(C.lds + C.wave * 9216 + 8192);
    for (int m = gw; m < T; m += NGW) {
        const int t = m & (SEQ - 1), b = m >> 11, n = t + 1; int* sel = WSP(int, WS_SEL) + (size_t)m * 256;
        if (n <= 256) { for (int i = lane; i < 256; i += 64) sel[i] = i < n ? i : 0; continue; }
        qs[lane] = *(const u32x4*)(WSP(h16s, WS_QI) + (size_t)m * 1536 + 1024 + lane * 8);
        float wq[8];
#pragma unroll
        for (int hh = 0; hh < 8; ++hh) wq[hh] = WSP(float, WS_WIDX)[(size_t)m * 8 + hh];
        LDS_WAIT(); asm volatile("" ::: "memory");
        const int nj = (n + 63) >> 6;
        for (int jj = 0; jj < nj; ++jj) { const int s = jj * 64 + lane; const int sr = s < n ? s : t;
            const u32x4* kp = (const u32x4*)(WSP(h16s, WS_KIDX) + ((size_t)b * SEQ + sr) * 64); u32x4 kr[8];
#pragma unroll
            for (int i = 0; i < 8; ++i) kr[i] = kp[i];
            float score = 0.f;
#pragma unroll
            for (int hh = 0; hh < 8; ++hh) { float d = 0.f;
#pragma unroll
                for (int i = 0; i < 8; ++i) { const u32x4 qv = qs[hh * 8 + i];
                    const f32x2 k0 = unpkh(kr[i].x), k1 = unpkh(kr[i].y), k2 = unpkh(kr[i].z), k3 = unpkh(kr[i].w), q0 = unpkh(qv.x), q1 = unpkh(qv.y), q2 = unpkh(qv.z), q3 = unpkh(qv.w);
                    d += k0[0] * q0[0]; d += k0[1] * q0[1]; d += k1[0] * q1[0]; d += k1[1] * q1[1]; d += k2[0] * q2[0]; d += k2[1] * q2[1]; d += k3[0] * q3[0]; d += k3[1] * q3[1]; }
                score += wq[hh] * fmaxf(d, 0.f); }
            sc[s] = score; }
        LDS_WAIT(); asm volatile("" ::: "memory");
        unsigned key[32];
#pragma unroll
        for (int jj = 0; jj < 32; ++jj) { const int s = jj * 64 + lane; key[jj] = (s < n) ? sortable(sc[s]) : 0u; }
        unsigned prefix = 0u;
        for (int bit = 31; bit >= 0; --bit) { const unsigned cand = prefix | (1u << bit); int cnt = 0;
#pragma unroll
            for (int jj = 0; jj < 32; ++jj) cnt += __builtin_popcountll(__ballot(key[jj] >= cand));
            if (cnt >= 256) prefix = cand; }
        int ngt = 0;
#pragma unroll
        for (int jj = 0; jj < 32; ++jj) ngt += __builtin_popcountll(__ballot(key[jj] > prefix));
        int need = 256 - ngt, base = 0; const unsigned long long lt = (1ull << lane) - 1ull;
#pragma unroll
        for (int jj = 0; jj < 32; ++jj) { const bool gt = key[jj] > prefix; const bool eq = key[jj] == prefix;
            const unsigned long long meq = __ballot(eq); const int eqrank = __builtin_popcountll(meq & lt); const bool take = gt || (eq && eqrank < need);
            const unsigned long long mt = __ballot(take); if (take) sel[base + __builtin_popcountll(mt & lt)] = jj * 64 + lane;
            base += __builtin_popcountll(mt); const int ne = __builtin_popcountll(meq); need -= (ne < need ? ne : need); }
        LDS_WAIT(); asm volatile("" ::: "memory");
    }
}
__device__ __forceinline__ void p8_attn_naive(Ctx& C) {
    const int tid = C.tid;
    LAS float* qf = (LAS float*)C.lds;
    LAS float* ql = qf + 1024;
    LAS float* sp = ql + 4096;
    LAS float* ol = sp + 4096;
    LAS int* sl = (LAS int*)(ol + 4096);
    const float* wuk = C.in[6]; const float* wuv = C.in[7];
    for (int m = C.bid; m < T; m += C.G) {
        const int t = m & (SEQ - 1), b = m >> 11, cnt = t + 1 < 256 ? t + 1 : 256;
        { const unsigned w = *(const unsigned*)(WSP(h16s, WS_QI) + (size_t)m * 1536 + tid * 2); const f32x2 f = unpkh(w); qf[tid * 2] = f[0]; qf[tid * 2 + 1] = f[1]; }
        if (tid < 256) sl[tid] = WSP(int, WS_SEL)[(size_t)m * 256 + tid];
        __syncthreads();
        { const int h = tid >> 5, r0 = (tid & 31) * 8; f32x4 a0 = (f32x4){0.f, 0.f, 0.f, 0.f}, a1 = a0;
          for (int d = 0; d < 64; ++d) { const float qv = qf[h * 64 + d]; const float* wp = wuk + ((size_t)(h * 64 + d)) * 256 + r0; a0 += qv * *(const f32x4*)wp; a1 += qv * *(const f32x4*)(wp + 4); }
          *(LAS f32x4*)(ql + h * 256 + r0) = a0; *(LAS f32x4*)(ql + h * 256 + r0 + 4) = a1; }
        __syncthreads();
        { const int k = tid & 255, hg = tid >> 8; float acc[8];
#pragma unroll
          for (int i = 0; i < 8; ++i) acc[i] = 0.f;
          if (k < cnt) { const u32x4* kv = (const u32x4*)(WSP(h16s, WS_PQ) + ((size_t)b * SEQ + sl[k]) * 512 + 256);
            for (int rc = 0; rc < 32; ++rc) { const u32x4 w = kv[rc]; const f32x2 x0 = unpkh(w.x), x1 = unpkh(w.y), x2 = unpkh(w.z), x3 = unpkh(w.w);
#pragma unroll
                for (int i = 0; i < 8; ++i) { const LAS float* qp = ql + (hg * 8 + i) * 256 + rc * 8; const f32x4 q0 = *(const LAS f32x4*)qp, q1 = *(const LAS f32x4*)(qp + 4);
                    acc[i] += (x0[0] * q0.x + x0[1] * q0.y) + (x1[0] * q0.z + x1[1] * q0.w) + (x2[0] * q1.x + x2[1] * q1.y) + (x3[0] * q1.z + x3[1] * q1.w); } } }
#pragma unroll
          for (int i = 0; i < 8; ++i) sp[(hg * 8 + i) * 256 + k] = (k < cnt) ? acc[i] * 0.125f : -INFINITY; }
        __syncthreads();
        { const int lane = C.lane;
#pragma unroll
          for (int hh = 0; hh < 2; ++hh) { LAS float* row = sp + (C.wave * 2 + hh) * 256; float v[4]; float mx = -INFINITY;
#pragma unroll
            for (int i = 0; i < 4; ++i) { v[i] = row[i * 64 + lane]; mx = fmaxf(mx, v[i]); }
#pragma unroll
            for (int o = 1; o < 64; o <<= 1) mx = fmaxf(mx, __shfl_xor(mx, o));
            float sum = 0.f;
#pragma unroll
            for (int i = 0; i < 4; ++i) { v[i] = expf(v[i] - mx); sum += v[i]; }
            sum = wave_sum(sum); const float inv = 1.f / sum;
#pragma unroll
            for (int i = 0; i < 4; ++i) row[i * 64 + lane] = v[i] * inv; } }
        __syncthreads();
        { const int r = tid & 255, hg = tid >> 8; float acc[8];
#pragma unroll
          for (int i = 0; i < 8; ++i) acc[i] = 0.f;
          const h16s* kvb = WSP(h16s, WS_PQ) + (size_t)b * SEQ * 512 + 256 + r;
          for (int k = 0; k < cnt; ++k) { const float x = h2f(kvb[(size_t)sl[k] * 512]);
#pragma unroll
              for (int i = 0; i < 8; ++i) acc[i] += sp[(hg * 8 + i) * 256 + k] * x; }
#pragma unroll
          for (int i = 0; i < 8; ++i) ol[(hg * 8 + i) * 256 + r] = acc[i]; }
        __syncthreads();
        { const int h = tid >> 5, d0 = (tid & 31) * 2; float a0 = 0.f, a1 = 0.f;
          for (int r = 0; r < 256; ++r) { const float x = ol[h * 256 + r]; const f32x2 w = *(const f32x2*)(wuv + ((size_t)(h * 256 + r)) * 64 + d0); a0 += x * w.x; a1 += x * w.y; }
          *(unsigned*)(WSP(h16s, WS_OA) + (size_t)m * 1024 + h * 64 + d0) = pkh(a0, a1); }
        __syncthreads();
    }
}


typedef short v4i16_t __attribute__((ext_vector_type(4)));
__device__ __forceinline__ h16x4 tr_read(LAS unsigned char* p) { return __builtin_bit_cast(h16x4, __builtin_amdgcn_ds_read_tr16_b64_v4i16((LAS v4i16_t*)p)); }
#define MFMA16(a, b, c) __builtin_amdgcn_mfma_f32_16x16x32_f16((a), (b), (c), 0, 0, 0)
__device__ __forceinline__ void p8_attn_mfma(Ctx& C) {
    const int lane = C.lane, wave = C.wave, l15 = lane & 15, g = lane >> 4;
    LAS unsigned char* QL = C.lds;
    LAS unsigned char* KVS = C.lds + wave * 17408;
    const h16s* QI = WSP(h16s, WS_QI); const h16s* PQ = WSP(h16s, WS_PQ); const int* SEL = WSP(int, WS_SEL);
    const h16s* WUKT = WSP(h16s, WS_WUKT); const h16s* WUVT = WSP(h16s, WS_WUVT); h16s* OA = WSP(h16s, WS_OA);
    const float SC = 0.125f * 1.4426950408889634f;
    const int ngrp = T / 8;
    for (int it = 0;; ++it) {
        int gi;
        if (C.G == 256) { if (it >= 8) break; gi = (C.bid & 7) * 256 + (C.bid >> 3) + 32 * it; } else { gi = C.bid + it * C.G; if (gi >= ngrp) break; }
        const int m0 = gi * 8, b = m0 >> 11;
#pragma unroll 1
        for (int hh = 0; hh < 2; ++hh) { const int h = 2 * wave + hh;
            const h16s* qp = QI + (size_t)(m0 + (l15 & 7)) * 1536 + h * 64 + 8 * g;
            const h16x8 qb0 = *(const h16x8*)qp, qb1 = *(const h16x8*)(qp + 32);
            const h16s* wp = WUKT + ((size_t)(h * 256 + l15)) * 64 + 8 * g;
#pragma unroll 2
            for (int rt = 0; rt < 16; ++rt) {
                const h16x8 a0 = *(const h16x8*)(wp + rt * 1024), a1 = *(const h16x8*)(wp + rt * 1024 + 32);
                f32x4 acc = (f32x4){0.f, 0.f, 0.f, 0.f};
                acc = MFMA16(a0, qb0, acc); acc = MFMA16(a1, qb1, acc);
                if (l15 < 8) { const int c16 = 2 * rt + (g >> 1); u32x2 w; w.x = pkh(acc[0], acc[1]); w.y = pkh(acc[2], acc[3]);
                    *(LAS u32x2*)(QL + l15 * 8192 + h * 512 + ((c16 ^ (h & 15)) * 16) + (g & 1) * 8) = w; }
            }
        }
        LDS_WAIT(); __syncthreads();
        h16x8 qB[8];
#pragma unroll
        for (int i = 0; i < 8; ++i) qB[i] = *(const LAS h16x8*)(QL + wave * 8192 + l15 * 512 + (((4 * i + g) ^ l15) * 16));
        LDS_WAIT(); __syncthreads();
        const int m = m0 + wave, t = m & (SEQ - 1), cnt = (t + 1 < 256) ? t + 1 : 256, nsteps = (cnt + 31) >> 5;
        const int* selp = SEL + (size_t)m * 256;
        const unsigned char* kvbase = (const unsigned char*)(PQ + (size_t)b * SEQ * 512 + 256) + g * 16;
        f32x4 O[16];
#pragma unroll
        for (int rt = 0; rt < 16; ++rt) O[rt] = (f32x4){0.f, 0.f, 0.f, 0.f};
        float m2 = -INFINITY, lsum = 0.f;
        h16x8 kv[2][8];
        int ia0, ia1, ib0, ib1;
        { const int k0 = l15, k1 = 16 + l15; ia0 = selp[k0 < cnt ? k0 : 0]; ia1 = selp[k1 < cnt ? k1 : 0]; const int k2 = 32 + l15, k3 = 48 + l15; ib0 = selp[k2 < cnt ? k2 : 0]; ib1 = selp[k3 < cnt ? k3 : 0]; }
#pragma unroll
        for (int i = 0; i < 8; ++i) { kv[0][i] = *(const h16x8*)(kvbase + (size_t)ia0 * 1024 + i * 64); kv[1][i] = *(const h16x8*)(kvbase + (size_t)ia1 * 1024 + i * 64); }
#pragma unroll 1
        for (int st = 0; st < nsteps; ++st) {
            int ic0, ic1; { const int k0 = (st + 2) * 32 + l15, k1 = k0 + 16; ic0 = selp[k0 < cnt ? k0 : 0]; ic1 = selp[k1 < cnt ? k1 : 0]; }
            f32x4 s0 = (f32x4){0.f, 0.f, 0.f, 0.f}, s1 = s0;
#pragma unroll
            for (int i = 0; i < 8; ++i) { s0 = MFMA16(kv[0][i], qB[i], s0); s1 = MFMA16(kv[1][i], qB[i], s1); }
#pragma unroll
            for (int tl = 0; tl < 2; ++tl)
#pragma unroll
                for (int i = 0; i < 8; ++i) *(LAS h16x8*)(KVS + (tl * 16 + l15) * 544 + g * 16 + i * 64) = kv[tl][i];
            if (st + 1 < nsteps) {
#pragma unroll
                for (int i = 0; i < 8; ++i) { kv[0][i] = *(const h16x8*)(kvbase + (size_t)ib0 * 1024 + i * 64); kv[1][i] = *(const h16x8*)(kvbase + (size_t)ib1 * 1024 + i * 64); }
            }
            ib0 = ic0; ib1 = ic1;
            float v0[4], v1[4]; float tm = -INFINITY;
#pragma unroll
            for (int r = 0; r < 4; ++r) { const int k0 = st * 32 + 4 * g + r; v0[r] = (k0 < cnt) ? s0[r] * SC : -INFINITY; v1[r] = (k0 + 16 < cnt) ? s1[r] * SC : -INFINITY; tm = fmaxf(tm, fmaxf(v0[r], v1[r])); }
            tm = fmaxf(tm, __shfl_xor(tm, 16)); tm = fmaxf(tm, __shfl_xor(tm, 32));
            if (__any(tm > m2 + 8.f)) { const float mn = fmaxf(m2, tm); const float f = __builtin_amdgcn_exp2f(m2 - mn); m2 = mn; lsum *= f;
#pragma unroll
                for (int rt = 0; rt < 16; ++rt) O[rt] = O[rt] * f; }
            float p0[4], p1[4];
#pragma unroll
            for (int r = 0; r < 4; ++r) { p0[r] = __builtin_amdgcn_exp2f(v0[r] - m2); p1[r] = __builtin_amdgcn_exp2f(v1[r] - m2); lsum += p0[r] + p1[r]; }
            u32x4 pw; pw.x = pkh(p0[0], p0[1]); pw.y = pkh(p0[2], p0[3]); pw.z = pkh(p1[0], p1[1]); pw.w = pkh(p1[2], p1[3]);
            const h16x8 pf = __builtin_bit_cast(h16x8, pw);
            { LAS unsigned char* trb = KVS + (4 * g + (l15 >> 2)) * 544 + (l15 & 3) * 8;
#pragma unroll
              for (int rt = 0; rt < 16; ++rt) {
                const h16x4 lo = tr_read(trb + rt * 32);
                const h16x4 hi = tr_read(trb + 16 * 544 + rt * 32);
                const h16x8 a = (h16x8){lo[0], lo[1], lo[2], lo[3], hi[0], hi[1], hi[2], hi[3]};
                O[rt] = MFMA16(a, pf, O[rt]);
                if ((rt & 3) == 3) __builtin_amdgcn_sched_barrier(0); } }
        }
        lsum += __shfl_xor(lsum, 16); lsum += __shfl_xor(lsum, 32);
        const float inv = 1.f / lsum;
        LDS_WAIT(); __syncthreads();
#pragma unroll
        for (int rt = 0; rt < 16; ++rt) { const int c16 = 2 * rt + (g >> 1); u32x2 w; w.x = pkh(O[rt][0] * inv, O[rt][1] * inv); w.y = pkh(O[rt][2] * inv, O[rt][3] * inv);
            *(LAS u32x2*)(QL + wave * 8192 + l15 * 512 + ((c16 ^ ((wave & 3) << 2)) * 16) + (g & 1) * 8) = w; }
        LDS_WAIT(); __syncthreads();
#pragma unroll 1
        for (int hh = 0; hh < 2; ++hh) { const int h = 2 * wave + hh, tokr = l15 & 7;
#pragma unroll 1
            for (int dt = 0; dt < 4; ++dt) { const h16s* wp = WUVT + ((size_t)(h * 64 + dt * 16 + l15)) * 256 + 8 * g; f32x4 acc = (f32x4){0.f, 0.f, 0.f, 0.f};
#pragma unroll
                for (int ks = 0; ks < 8; ++ks) { const h16x8 a = *(const h16x8*)(wp + ks * 32);
                    const h16x8 bb = *(const LAS h16x8*)(QL + tokr * 8192 + h * 512 + (((4 * ks + g) ^ ((tokr & 3) << 2)) * 16));
                    acc = MFMA16(a, bb, acc); }
                if (l15 < 8) { u32x2 w; w.x = pkh(acc[0], acc[1]); w.y = pkh(acc[2], acc[3]); *(u32x2*)(OA + (size_t)(m0 + l15) * 1024 + h * 64 + dt * 16 + 4 * g) = w; }
            }
        }
        LDS_WAIT(); __syncthreads();
    }
}

__device__ __forceinline__ void p12_hn(Ctx& C) {
    const int gw = C.bid * NWAVES + C.wave, NGW = C.G * NWAVES;
    for (int m = gw; m < T; m += NGW) rms_row_f16(C.out + (size_t)m * DM, C.in[18], WSP(h16s, WS_PZ) + (size_t)m * DM, C.lane);
}
__device__ __forceinline__ void p15_final(Ctx& C) {
    const int gw = C.bid * NWAVES + C.wave, NGW = C.G * NWAVES, lane = C.lane;
    for (int m = gw; m < T; m += NGW) {
        f32x4* xr = (f32x4*)(C.out + (size_t)m * DM) + lane; const f32x4* gr = (const f32x4*)C.in[22] + lane;
        f32x4 v[4]; float s = 0.f;
#pragma unroll
        for (int j = 0; j < 4; ++j) { v[j] = xr[64 * j]; s += (v[j].x * v[j].x + v[j].y * v[j].y) + (v[j].z * v[j].z + v[j].w * v[j].w); }
        const float r = rsqrtf(wave_sum(s) * (1.f / 1024.f) + EPS);
#pragma unroll
        for (int j = 0; j < 4; ++j) { const f32x4 g = gr[64 * j]; xr[64 * j] = (f32x4){v[j].x * r * g.x, v[j].y * r * g.y, v[j].z * r * g.z, v[j].w * r * g.w}; }
    }
}

constexpr int N_PHASES = 16;
struct Args { const float* in[23]; float* out; unsigned char* ws; int ph_lo, ph_hi; };
__global__ void __launch_bounds__(NWAVES * 64, 2) mega_fwd(Args args) {
    extern __shared__ __attribute__((aligned(16))) unsigned char lds[];
    Ctx C;
    C.lds = (LAS unsigned char*)lds;
    C.tid = threadIdx.x; C.lane = C.tid & 63; C.wave = __builtin_amdgcn_readfirstlane(C.tid >> 6);
    C.G = gridDim.x; C.bid = blockIdx.x;
    C.in = args.in;
    C.out = args.out; C.ws = args.ws;
    volatile LAS unsigned* MISC = (volatile LAS unsigned*)(C.lds + MISC_OFF);
    for (int u = C.tid; u < (LDS_BYTES - RING_BYTES) / 4; u += NWAVES * 64) ((LAS unsigned*)(C.lds + RING_BYTES))[u] = 0u;
    __syncthreads();
    const int lo = args.ph_lo, hi = args.ph_hi;
    const bool multi = (hi - lo) > 1;
    XcdBarrier bar; bar.bar = (unsigned*)(C.ws + WS_CTL) + 4096; bar.x = 0; bar.st = nullptr;
    if (multi) bar = xcd_barrier_post((unsigned*)(C.ws + WS_CTL) + 4096, MISC + 8);
#define IN(k) (lo <= (k) && (k) < hi && ((C.lane = lane_id_asm()), (C.tid = (C.wave << 6) | C.lane), true))
#define SEAM(k) do { if (lo <= (k) && (k) + 1 < hi) xcd_barrier(bar); } while (0)
    typedef pg8::StaticOrder SO;
    if (IN(0)) { p0_prologue(C); } SEAM(0);
    if (IN(1)) { pg8::Gemm g{DOP(h16s, DO_H), DOP(h16s, DO_WIN), T, INWP, 1024, 1024, 1024}; SO S; S.init(T, INWP, C.G, C.bid);
        pg8::EpiProj E{WSP(h16s, WS_PQ), WSP(h16s, WS_PQKV), WSP(h16s, WS_PZ), WSP(h16s, WS_PG), WSP(float, WS_PS32)};
        pg8::gemm_phase<pg8::EpiProj, SO, true, true>(C.lds, g, S, E); } SEAM(1);
    if (IN(2)) { p2_prep(C); } SEAM(2);
    if (IN(3)) { p3_conv_inplace(C); } SEAM(3);
    if (IN(4)) { p4_scan_naive(C); } SEAM(4);
    if (IN(5)) { p5_gated_norm(C); } SEAM(5);
    if (IN(6)) { pg8::Gemm g{WSP(h16s, WS_PQ), WSP(h16s, WS_WQI), T, 1536, 256, 512, 256}; SO S; S.init(T, 1536, C.G, C.bid);
        pg8::EpiF16 E{WSP(h16s, WS_QI), 1536};
        pg8::gemm_phase<pg8::EpiF16, SO, true, true>(C.lds, g, S, E); } SEAM(6);
    if (IN(7)) { p7_topk_naive(C); } SEAM(7);
#ifdef NAIVE_ATTN
    if (IN(8)) { p8_attn_naive(C); } SEAM(8);
#else
    if (IN(8)) { p8_attn_mfma(C); } SEAM(8);
#endif
    if (IN(9)) { pg8::Gemm g{WSP(h16s, WS_OA), WSP(h16s, WS_WPA), T, 1024, 1024, 1024, 1024}; SO S; S.init(T, 1024, C.G, C.bid);
        pg8::EpiGateA E{WSP(h16s, WS_PG)};
        pg8::gemm_phase<pg8::EpiGateA, SO, true, true>(C.lds, g, S, E); } SEAM(9);
    if (IN(10)) { pg8::Gemm g{WSP(h16s, WS_PZ), WSP(h16s, WS_WPB), T, 1024, 1024, 1024, 1024}; SO S; S.init(T, 1024, C.G, C.bid);
        pg8::EpiMerge E{WSP(h16s, WS_PG)};
        pg8::gemm_phase<pg8::EpiMerge, SO, true, true>(C.lds, g, S, E); } SEAM(10);
    if (IN(11)) { pg8::Gemm g{WSP(h16s, WS_PG) + 1024, WSP(h16s, WS_WOUT), T, 1024, 1024, 2048, 1024}; SO S; S.init(T, 1024, C.G, C.bid);
        pg8::EpiRes E{C.in[0], C.out};
        pg8::gemm_phase<pg8::EpiRes, SO, true, true>(C.lds, g, S, E); } SEAM(11);
    if (IN(12)) { p12_hn(C); } SEAM(12);
    if (IN(13)) { pg8::Gemm g{WSP(h16s, WS_PZ), WSP(h16s, WS_WGU), T, 5632, 1024, 1024, 1024}; SO S; S.init(T, 5632, C.G, C.bid);
        pg8::EpiSwiglu E{WSP(h16s, WS_ACT)};
        pg8::gemm_phase<pg8::EpiSwiglu, SO, true, true>(C.lds, g, S, E); } SEAM(13);
    if (IN(14)) { pg8::Gemm g{WSP(h16s, WS_ACT), WSP(h16s, WS_WDN), T, 1024, 2816, 2816, 2816}; SO S; S.init(T, 1024, C.G, C.bid);
        pg8::EpiRes E{C.out, C.out};
        pg8::gemm_phase<pg8::EpiRes, SO, true, true>(C.lds, g, S, E); } SEAM(14);
    if (IN(15)) { p15_final(C); }
#undef IN
#undef SEAM
}

extern "C" void kernel_launch(void* const* d_in, const int* in_sizes, int n_in, void* d_out, int out_size, void* d_ws, size_t ws_size, hipStream_t stream) {
    static int grid = 0;
    if (grid == 0) {
        if (n_in != 23 || in_sizes[0] != T * DM || out_size != T * DM || ws_size < WS_END) { fprintf(stderr, "kernel_launch: unexpected shapes (n_in %d, in0 %d, out %d, ws %zu)\n", n_in, n_in > 0 ? in_sizes[0] : -1, out_size, ws_size); grid = -1; return; }
        int dev = 0, cus = 0, per_cu = 0;
        if (hipGetDevice(&dev) != hipSuccess || hipDeviceGetAttribute(&cus, hipDeviceAttributeMultiprocessorCount, dev) != hipSuccess) { grid = -1; return; }
        if (hipFuncSetAttribute((const void*)mega_fwd, hipFuncAttributeMaxDynamicSharedMemorySize, LDS_BYTES) != hipSuccess) { fprintf(stderr, "kernel_launch: hipFuncSetAttribute failed\n"); grid = -1; return; }
        if (hipOccupancyMaxActiveBlocksPerMultiprocessor(&per_cu, (const void*)mega_fwd, NWAVES * 64, LDS_BYTES) != hipSuccess || per_cu < 1) { fprintf(stderr, "kernel_launch: occupancy query says %d\n", per_cu); per_cu = 1; }
        (void)hipGetLastError();
        grid = cus;
    }
    if (grid < 0) return;
    (void)hipMemsetAsync((char*)d_ws + WS_CTL, 0, CTL_ZERO_BYTES, stream);
    Args a{};
    for (int i = 0; i < 23; ++i) a.in[i] = (const float*)d_in[i];
    a.out = (float*)d_out; a.ws = (unsigned char*)d_ws;
#ifdef MULTI_LAUNCH
    for (int p = 0; p < N_PHASES; ++p) { a.ph_lo = p; a.ph_hi = p + 1; hipLaunchKernelGGL(mega_fwd, dim3(grid), dim3(NWAVES * 64), LDS_BYTES, stream, a); }
#else
    a.ph_lo = 0; a.ph_hi = N_PHASES; hipLaunchKernelGGL(mega_fwd, dim3(grid), dim3(NWAVES * 64), LDS_BYTES, stream, a);
#endif
}
```

```cpp
#include <hip/hip_runtime.h>
#include <cstdio>
#include <cstdint>

#define GAS __attribute__((address_space(1)))
#define LAS __attribute__((address_space(3)))
typedef unsigned short h16s;
typedef _Float16 h16;
typedef h16 h16x8 __attribute__((ext_vector_type(8)));
typedef h16 h16x4 __attribute__((ext_vector_type(4)));
typedef h16 h16x2 __attribute__((ext_vector_type(2)));
typedef float f32x2 __attribute__((ext_vector_type(2)));
typedef float f32x4 __attribute__((ext_vector_type(4)));
typedef float f32x16 __attribute__((ext_vector_type(16)));
typedef unsigned u32x4 __attribute__((ext_vector_type(4)));
typedef unsigned u32x2 __attribute__((ext_vector_type(2)));

__device__ __forceinline__ unsigned pkh(float lo, float hi) { f32x2 v = {lo, hi}; h16x2 h = __builtin_convertvector(v, h16x2); return __builtin_bit_cast(unsigned, h); }
__device__ __forceinline__ f32x2 unpkh(unsigned u) { h16x2 h = __builtin_bit_cast(h16x2, u); return (f32x2){(float)h[0], (float)h[1]}; }
__device__ __forceinline__ float h2f(h16s s) { return (float)__builtin_bit_cast(h16, s); }
__device__ __forceinline__ h16s f2h(float f) { return __builtin_bit_cast(h16s, (h16)f); }
__device__ __forceinline__ float sigmoidf_(float x) { return __builtin_amdgcn_rcpf(1.f + __expf(-x)); }
__device__ __forceinline__ float siluf_(float x) { return x * __builtin_amdgcn_rcpf(1.f + __expf(-x)); }

namespace pg8 {
#define PG8_LAS __attribute__((address_space(3)))
typedef unsigned short bf16_t;
constexpr int BM = 256, BK = 64, HALF = 128, HTB = HALF * BK * 2  , STAGE_BYTES = 8 * HTB, NXCD = 8, WGM = 8;

__host__ __device__ __forceinline__ int lds_byte(int r, int c) { const int st = (r >> 4) * 2 + (c >> 5), rr = r & 15, cc = c & 31, ob = rr * 64 + cc * 2; return st * 1024 + (ob ^ (((ob >> 9) & 1) << 5)); }
__host__ __device__ __forceinline__ void stage_rc(int b, int& R, int& C) { const int st = b / 1024, sb = b % 1024, swz = sb ^ (((sb >> 9) & 1) << 5); R = (st >> 1) * 16 + swz / 64; C = (st & 1) * 32 + (swz % 64) / 2; }
__host__ __device__ __forceinline__ int perm32(int rho) { const int n = rho >> 4, i = rho & 15; return 8 * (i >> 2) + 4 * n + (i & 3); }

struct Unit { int pm, pn; };
struct Gemm { const bf16_t* A; const bf16_t* Bt; int M, N, K, lda, ldb; };

struct StaticOrder {
    int nM, nN, nwg, G, c;
    __host__ __device__ void init(int M, int N, int G_, int c_) { nM = M / BM; nN = N / BM; nwg = nM * nN; G = G_; c = c_; }
    __host__ __device__ bool next(int i, Unit& u) const {
        const long L = (long)i * G + c; if (L >= nwg) return false;
        int wgid = (int)L; { const int q = nwg / NXCD, r = nwg % NXCD, xcd = wgid % NXCD, off = wgid / NXCD; wgid = (xcd < r ? xcd * (q + 1) : r * (q + 1) + (xcd - r) * q) + off; }
        const int nig = WGM * nN, gid = wgid / nig, fm = gid * WGM, gsz = (nM - fm) < WGM ? (nM - fm) : WGM;
        u.pm = fm + ((wgid % nig) % gsz); u.pn = (wgid % nig) / gsz; return true;
    }
    __device__ __forceinline__ void a_ready(const Unit&) const {}
    __device__ __forceinline__ void done(const Unit&) const {}
};

__device__ __forceinline__ u32x4 pack8(const f32x4& a, const f32x4& b) { u32x4 w; w.x = pkh(a[0], a[1]); w.y = pkh(a[2], a[3]); w.z = pkh(b[0], b[1]); w.w = pkh(b[2], b[3]); return w; }

struct EpiF16 {
    static constexpr bool PERM = true, AFTER_DRAIN = false;
    bf16_t* O; int ldc;
    __device__ __forceinline__ void operator()(const f32x4 (&acc)[2][2][4][2], const Unit& u, int wr, int wc, int fr, int fq) const {
        const int row0 = u.pm * BM + wr * 64 + fr, col0 = u.pn * BM + wc * 32 + 8 * fq;
#pragma unroll
        for (int ai = 0; ai < 2; ++ai)
#pragma unroll
            for (int m = 0; m < 4; ++m) { bf16_t* rowp = O + (size_t)(row0 + ai * HALF + m * 16) * ldc + col0;
#pragma unroll
                for (int bj = 0; bj < 2; ++bj) *(u32x4*)(rowp + bj * HALF) = pack8(acc[ai][bj][m][0], acc[ai][bj][m][1]); }
    }
};
struct EpiProj {
    static constexpr bool PERM = true, AFTER_DRAIN = false;
    bf16_t *PQ, *PQKV, *PZ, *PG; float* PS32;
    __device__ __forceinline__ void operator()(const f32x4 (&acc)[2][2][4][2], const Unit& u, int wr, int wc, int fr, int fq) const {
        const int row0 = u.pm * BM + wr * 64 + fr, cw = wc * 32 + 8 * fq;
        if (u.pn == 26) {
#pragma unroll
            for (int ai = 0; ai < 2; ++ai)
#pragma unroll
                for (int m = 0; m < 4; ++m) { float* rowp = PS32 + (size_t)(row0 + ai * HALF + m * 16) * 256 + cw;
#pragma unroll
                    for (int bj = 0; bj < 2; ++bj) { *(f32x4*)(rowp + bj * HALF) = acc[ai][bj][m][0]; *(f32x4*)(rowp + bj * HALF + 4) = acc[ai][bj][m][1]; } }
        } else {
            bf16_t* base; int ldc, c0;
            if (u.pn < 2) { base = PQ; ldc = 512; c0 = u.pn * 256; } else if (u.pn < 14) { base = PQKV; ldc = 3072; c0 = (u.pn - 2) * 256; }
            else if (u.pn < 18) { base = PZ; ldc = 1024; c0 = (u.pn - 14) * 256; } else { base = PG; ldc = 2048; c0 = (u.pn - 18) * 256; }
#pragma unroll
            for (int ai = 0; ai < 2; ++ai)
#pragma unroll
                for (int m = 0; m < 4; ++m) { bf16_t* rowp = base + (size_t)(row0 + ai * HALF + m * 16) * ldc + c0 + cw;
#pragma unroll
                    for (int bj = 0; bj < 2; ++bj) *(u32x4*)(rowp + bj * HALF) = pack8(acc[ai][bj][m][0], acc[ai][bj][m][1]); }
        }
    }
};
struct EpiGateA {
    static constexpr bool PERM = true, AFTER_DRAIN = false;
    bf16_t* PG;
    __device__ __forceinline__ void operator()(const f32x4 (&acc)[2][2][4][2], const Unit& u, int wr, int wc, int fr, int fq) const {
        const int row0 = u.pm * BM + wr * 64 + fr, col0 = u.pn * BM + wc * 32 + 8 * fq;
#pragma unroll
        for (int ai = 0; ai < 2; ++ai)
#pragma unroll
            for (int m = 0; m < 4; ++m) { bf16_t* rowp = PG + (size_t)(row0 + ai * HALF + m * 16) * 2048 + col0;
#pragma unroll
                for (int bj = 0; bj < 2; ++bj) { const u32x4 g = *(const u32x4*)(rowp + bj * HALF); f32x4 o0, o1;
                    const f32x2 g0 = unpkh(g.x), g1 = unpkh(g.y), g2 = unpkh(g.z), g3 = unpkh(g.w);
                    o0[0] = sigmoidf_(g0[0]) * acc[ai][bj][m][0][0]; o0[1] = sigmoidf_(g0[1]) * acc[ai][bj][m][0][1]; o0[2] = sigmoidf_(g1[0]) * acc[ai][bj][m][0][2]; o0[3] = sigmoidf_(g1[1]) * acc[ai][bj][m][0][3];
                    o1[0] = sigmoidf_(g2[0]) * acc[ai][bj][m][1][0]; o1[1] = sigmoidf_(g2[1]) * acc[ai][bj][m][1][1]; o1[2] = sigmoidf_(g3[0]) * acc[ai][bj][m][1][2]; o1[3] = sigmoidf_(g3[1]) * acc[ai][bj][m][1][3];
                    *(u32x4*)(rowp + bj * HALF) = pack8(o0, o1); } }
    }
};
struct EpiMerge {
    static constexpr bool PERM = true, AFTER_DRAIN = false;
    bf16_t* PG;
    __device__ __forceinline__ void operator()(const f32x4 (&acc)[2][2][4][2], const Unit& u, int wr, int wc, int fr, int fq) const {
        const int row0 = u.pm * BM + wr * 64 + fr, col0 = u.pn * BM + wc * 32 + 8 * fq;
#pragma unroll
        for (int ai = 0; ai < 2; ++ai)
#pragma unroll
            for (int m = 0; m < 4; ++m) { bf16_t* rowp = PG + (size_t)(row0 + ai * HALF + m * 16) * 2048 + col0;
#pragma unroll
                for (int bj = 0; bj < 2; ++bj) { const u32x4 t = *(const u32x4*)(rowp + bj * HALF); const u32x4 g = *(const u32x4*)(rowp + 1024 + bj * HALF); f32x4 o0, o1;
                    const f32x2 g0 = unpkh(g.x), g1 = unpkh(g.y), g2 = unpkh(g.z), g3 = unpkh(g.w), t0 = unpkh(t.x), t1 = unpkh(t.y), t2 = unpkh(t.z), t3 = unpkh(t.w);
                    o0[0] = t0[0] + sigmoidf_(g0[0]) * acc[ai][bj][m][0][0]; o0[1] = t0[1] + sigmoidf_(g0[1]) * acc[ai][bj][m][0][1]; o0[2] = t1[0] + sigmoidf_(g1[0]) * acc[ai][bj][m][0][2]; o0[3] = t1[1] + sigmoidf_(g1[1]) * acc[ai][bj][m][0][3];
                    o1[0] = t2[0] + sigmoidf_(g2[0]) * acc[ai][bj][m][1][0]; o1[1] = t2[1] + sigmoidf_(g2[1]) * acc[ai][bj][m][1][1]; o1[2] = t3[0] + sigmoidf_(g3[0]) * acc[ai][bj][m][1][2]; o1[3] = t3[1] + sigmoidf_(g3[1]) * acc[ai][bj][m][1][3];
                    *(u32x4*)(rowp + 1024 + bj * HALF) = pack8(o0, o1); } }
    }
};
struct EpiRes {
    static constexpr bool PERM = false, AFTER_DRAIN = false;
    const float* base; float* out;
    __device__ __forceinline__ void operator()(const f32x4 (&acc)[2][2][4][2], const Unit& u, int wr, int wc, int fr, int fq) const {
        const int row0 = u.pm * BM + wr * 64 + fr, col0 = u.pn * BM + wc * 32 + 4 * fq;
#pragma unroll
        for (int ai = 0; ai < 2; ++ai)
#pragma unroll
            for (int m = 0; m < 4; ++m) { const size_t off = (size_t)(row0 + ai * HALF + m * 16) * 1024 + col0;
#pragma unroll
                for (int bj = 0; bj < 2; ++bj)
#pragma unroll
                    for (int n = 0; n < 2; ++n) { const f32x4 b = *(const f32x4*)(base + off + bj * HALF + n * 16); *(f32x4*)(out + off + bj * HALF + n * 16) = b + acc[ai][bj][m][n]; } }
    }
};
struct EpiSwiglu {
    static constexpr bool PERM = true, AFTER_DRAIN = false;
    bf16_t* ACT;
    __device__ __forceinline__ void operator()(const f32x4 (&acc)[2][2][4][2], const Unit& u, int wr, int wc, int fr, int fq) const {
        const int row0 = u.pm * BM + wr * 64 + fr, col0 = u.pn * HALF + wc * 32 + 8 * fq;
#pragma unroll
        for (int ai = 0; ai < 2; ++ai)
#pragma unroll
            for (int m = 0; m < 4; ++m) { f32x4 o0, o1;
#pragma unroll
                for (int e = 0; e < 4; ++e) { o0[e] = siluf_(acc[ai][0][m][0][e]) * acc[ai][1][m][0][e]; o1[e] = siluf_(acc[ai][0][m][1][e]) * acc[ai][1][m][1][e]; }
                *(u32x4*)(ACT + (size_t)(row0 + ai * HALF + m * 16) * 2816 + col0) = pack8(o0, o1); }
    }
};

template <class Epi, class Sched, bool ALIGN_EPI = false, bool SP2 = false>
__device__ __forceinline__ void gemm_phase(PG8_LAS unsigned char* lds, const Gemm g, const Sched& S, const Epi& E, int tid_in) {
    const int tid = tid_in, wid = __builtin_amdgcn_readfirstlane(tid >> 6), lane = tid & 63, wr = wid >> 2, wc = wid & 3, fr = lane & 15, fq = lane >> 4;
    int K = g.K; asm volatile("" : "+s"(K));
    const int nt = K / BK;
    unsigned voffA[2], voffB[2];
#pragma unroll
    for (int i = 0; i < 2; ++i) { int R, C; stage_rc(tid * 16 + i * 8192, R, C); const int Rb = Epi::PERM ? ((R & ~31) + perm32(R & 31)) : R;
        voffA[i] = (unsigned)(R * g.lda + C) * 2u; voffB[i] = (unsigned)(Rb * g.ldb + C) * 2u; }
    const size_t kstep = (size_t)(BK * 2);
    const size_t hstepA = (size_t)HALF * g.lda * 2, hstepB = (size_t)HALF * g.ldb * 2;
    const size_t tstepA = 2 * hstepA, tstepB = 2 * hstepB;
    const unsigned ldsw = (unsigned)wid * 1024u;
    const int aoff = lds_byte(wr * 64 + fr, fq * 8), boff = lds_byte(wc * 32 + fr, fq * 8);
#define PG8_SA(b, h) (((b) * 2 + (h)) * HTB)
#define PG8_SB(b, h) ((4 + (b) * 2 + (h)) * HTB)
#define PG8_STAGE(bufoff, gbase, voff) do { _Pragma("unroll") for (int _i = 0; _i < 2; ++_i) \
        __builtin_amdgcn_global_load_lds((const unsigned*)((const char*)(gbase) + (voff)[_i]), (PG8_LAS unsigned*)(lds + (bufoff) + ldsw + _i * 8192), 16, 0, 0); } while (0)
#define PG8_LDA(dst, b, h) do { _Pragma("unroll") for (int m = 0; m < 4; ++m) _Pragma("unroll") for (int k = 0; k < 2; ++k) dst[m][k] = *(const PG8_LAS h16x8*)(lds + PG8_SA(b, h) + aoff + m * 2048 + k * 1024); } while (0)
#define PG8_LDB(dst, b, h) do { _Pragma("unroll") for (int n = 0; n < 2; ++n) _Pragma("unroll") for (int k = 0; k < 2; ++k) dst[n][k] = *(const PG8_LAS h16x8*)(lds + PG8_SB(b, h) + boff + n * 2048 + k * 1024); } while (0)
#define PG8_MMA(ai, bj, At, Bt) do { __builtin_amdgcn_s_setprio(1); _Pragma("unroll") for (int m = 0; m < 4; ++m) _Pragma("unroll") for (int n = 0; n < 2; ++n) _Pragma("unroll") for (int k = 0; k < 2; ++k) \
        acc[ai][bj][m][n] = __builtin_amdgcn_mfma_f32_16x16x32_f16(Bt[n][k], At[m][k], acc[ai][bj][m][n], 0, 0, 0); __builtin_amdgcn_s_setprio(0); } while (0)
#define PG8_WAIT_V(n) asm volatile("s_waitcnt vmcnt(" #n ")" ::: "memory")
#define PG8_WAIT_L(n) asm volatile("s_waitcnt lgkmcnt(" #n ")" ::: "memory")
#define PG8_BAR __builtin_amdgcn_s_barrier()
#define PG8_SCHED __builtin_amdgcn_sched_barrier(0)
    Unit cur, nxt; int ui = 0;
    if (!S.next(0, cur)) return;
    f32x4 acc[2][2][4][2];
#pragma unroll
    for (int a = 0; a < 2; ++a)
#pragma unroll
        for (int b = 0; b < 2; ++b)
#pragma unroll
            for (int m = 0; m < 4; ++m)
#pragma unroll
                for (int n = 0; n < 2; ++n) acc[a][b][m][n] = (f32x4){0.f, 0.f, 0.f, 0.f};
    h16x8 At[4][2], B0[2][2], B1[2][2];
    const char* cA = (const char*)g.A + (size_t)cur.pm * tstepA; const char* cB = (const char*)g.Bt + (size_t)cur.pn * tstepB;
    S.a_ready(cur);
    if constexpr (SP2) {
        PG8_STAGE(PG8_SB(0, 0), cB, voffB); PG8_STAGE(PG8_SB(0, 1), cB + hstepB, voffB); PG8_STAGE(PG8_SA(0, 0), cA, voffA); PG8_STAGE(PG8_SA(0, 1), cA + hstepA, voffA);
        if (wr == 1) PG8_BAR;
        PG8_WAIT_V(2); PG8_BAR;
        PG8_STAGE(PG8_SB(1, 0), cB + kstep, voffB); PG8_STAGE(PG8_SA(1, 0), cA + kstep, voffA); PG8_STAGE(PG8_SB(1, 1), cB + hstepB + kstep, voffB);
        PG8_WAIT_V(6); PG8_BAR;
    } else {
        PG8_STAGE(PG8_SB(0, 0), cB, voffB); PG8_STAGE(PG8_SA(0, 0), cA, voffA); PG8_STAGE(PG8_SB(0, 1), cB + hstepB, voffB); PG8_STAGE(PG8_SA(0, 1), cA + hstepA, voffA);
        if (wr == 1) PG8_BAR;
        PG8_WAIT_V(4); PG8_BAR;
        PG8_STAGE(PG8_SB(1, 0), cB + kstep, voffB); PG8_STAGE(PG8_SA(1, 0), cA + kstep, voffA); PG8_STAGE(PG8_SB(1, 1), cB + hstepB + kstep, voffB);
        PG8_WAIT_V(6); PG8_BAR;
    }
    for (;;) {
        const bool has_next = S.next(ui + 1, nxt);
        const char* nA = has_next ? (const char*)g.A + (size_t)nxt.pm * tstepA : cA; const char* nB = has_next ? (const char*)g.Bt + (size_t)nxt.pn * tstepB : cB;
        for (int t = 0; t < nt; t += 2) {
            const bool last = (t == nt - 2);
            const char* a1 = cA + (size_t)(t + 1) * kstep;
            const char* a2 = last ? nA : cA + (size_t)(t + 2) * kstep; const char* b2 = last ? nB : cB + (size_t)(t + 2) * kstep;
            const char* a3 = a2 + kstep; const char* b3 = b2 + kstep;
            if (last && has_next) S.a_ready(nxt);
            if constexpr (SP2) {
            PG8_LDB(B0, 0, 0); PG8_LDB(B1, 0, 1); PG8_SCHED; PG8_LDA(At, 0, 0); PG8_STAGE(PG8_SA(1, 1), a1 + hstepA, voffA);
            PG8_WAIT_V(8); PG8_WAIT_L(0); PG8_BAR; PG8_MMA(0, 0, At, B0); PG8_MMA(0, 1, At, B1); PG8_BAR; PG8_SCHED;
            PG8_LDA(At, 0, 1); PG8_STAGE(PG8_SB(0, 0), b2, voffB); PG8_STAGE(PG8_SB(0, 1), b2 + hstepB, voffB); PG8_STAGE(PG8_SA(0, 0), a2, voffA);
            PG8_WAIT_V(8); PG8_WAIT_L(0); PG8_BAR; PG8_MMA(1, 0, At, B0); PG8_MMA(1, 1, At, B1); PG8_BAR; PG8_SCHED;
            PG8_LDB(B0, 1, 0); PG8_LDB(B1, 1, 1); PG8_SCHED; PG8_LDA(At, 1, 0); PG8_STAGE(PG8_SA(0, 1), a2 + hstepA, voffA);
            PG8_WAIT_V(8); PG8_WAIT_L(0); PG8_BAR; PG8_MMA(0, 0, At, B0); PG8_MMA(0, 1, At, B1); PG8_BAR; PG8_SCHED;
            PG8_LDA(At, 1, 1); PG8_STAGE(PG8_SB(1, 0), b3, voffB); PG8_STAGE(PG8_SB(1, 1), b3 + hstepB, voffB); PG8_STAGE(PG8_SA(1, 0), a3, voffA);
            PG8_WAIT_V(8); PG8_WAIT_L(0); PG8_BAR; PG8_MMA(1, 0, At, B0); PG8_MMA(1, 1, At, B1); PG8_BAR; PG8_SCHED;
            } else {
            PG8_LDB(B0, 0, 0); PG8_SCHED; PG8_LDA(At, 0, 0); PG8_STAGE(PG8_SA(1, 1), a1 + hstepA, voffA);
            PG8_WAIT_L(8); PG8_BAR; PG8_WAIT_L(0); PG8_MMA(0, 0, At, B0); PG8_BAR; PG8_SCHED;
            PG8_LDB(B1, 0, 1); PG8_STAGE(PG8_SB(0, 0), b2, voffB);
            PG8_BAR; PG8_WAIT_L(0); PG8_MMA(0, 1, At, B1); PG8_BAR;
            PG8_LDA(At, 0, 1); PG8_STAGE(PG8_SA(0, 0), a2, voffA);
            PG8_BAR; PG8_WAIT_L(0); PG8_MMA(1, 0, At, B0); PG8_BAR; PG8_SCHED;
            PG8_STAGE(PG8_SB(0, 1), b2 + hstepB, voffB);
            PG8_WAIT_V(6); PG8_BAR; PG8_MMA(1, 1, At, B1); PG8_BAR;
            PG8_LDB(B0, 1, 0); PG8_SCHED; PG8_LDA(At, 1, 0); PG8_STAGE(PG8_SA(0, 1), a2 + hstepA, voffA);
            PG8_WAIT_L(8); PG8_BAR; PG8_WAIT_L(0); PG8_MMA(0, 0, At, B0); PG8_BAR; PG8_SCHED;
            PG8_LDB(B1, 1, 1); PG8_STAGE(PG8_SB(1, 0), b3, voffB);
            PG8_BAR; PG8_WAIT_L(0); PG8_MMA(0, 1, At, B1); PG8_BAR;
            PG8_LDA(At, 1, 1); PG8_STAGE(PG8_SA(1, 0), a3, voffA);
            PG8_BAR; PG8_WAIT_L(0); PG8_MMA(1, 0, At, B0); PG8_BAR; PG8_SCHED;
            PG8_STAGE(PG8_SB(1, 1), b3 + hstepB, voffB);
            PG8_WAIT_V(6); PG8_BAR; PG8_MMA(1, 1, At, B1); PG8_BAR;
            }
        }
        if constexpr (ALIGN_EPI) { if (wr == 0) PG8_BAR; }
        if constexpr (!Epi::AFTER_DRAIN) { E(acc, cur, wr, wc, fr, fq); S.done(cur); }
        if (!has_next) break;
#pragma unroll
        for (int a = 0; a < 2; ++a)
#pragma unroll
            for (int b = 0; b < 2; ++b)
#pragma unroll
                for (int m = 0; m < 4; ++m)
#pragma unroll
                    for (int n = 0; n < 2; ++n) acc[a][b][m][n] = (f32x4){0.f, 0.f, 0.f, 0.f};
        cur = nxt; cA = nA; cB = nB; ++ui;
        if constexpr (ALIGN_EPI) { if (wr == 1) PG8_BAR; }
    }
    PG8_WAIT_V(0);
    if constexpr (!ALIGN_EPI) { if (wr == 0) PG8_BAR; }
    PG8_BAR;
    if constexpr (Epi::AFTER_DRAIN) { E.fused(acc, cur, wr, wc, fr, fq, lds, wid, lane); S.done(cur); }
#undef PG8_SA
#undef PG8_SB
#undef PG8_STAGE
#undef PG8_LDA
#undef PG8_LDB
#undef PG8_MMA
#undef PG8_WAIT_V
#undef PG8_WAIT_L
#undef PG8_BAR
#undef PG8_SCHED
}
}
#define XB_TMO      128
#define XB_XCNT(j)  (256  + 64 * (j))
#define XB_XSUB(j)  (1280 + 64 * (j))
#define XB_XGEN(j)  (2304 + 64 * (j))
#define XB_TOP      3328
#define XB_TOPGEN   3392
#define XCD_BAR_WORDS 3456
#define XB_SPIN_CAP (1u << 23)

__device__ __forceinline__ unsigned xb_ld(unsigned* p)              { return __hip_atomic_load(p, __ATOMIC_RELAXED, __HIP_MEMORY_SCOPE_AGENT); }
__device__ __forceinline__ unsigned xb_add(unsigned* p, unsigned v) { return __hip_atomic_fetch_add(p, v, __ATOMIC_RELAXED, __HIP_MEMORY_SCOPE_AGENT); }
__device__ __forceinline__ unsigned xb_xcc_id() { return (unsigned)__builtin_amdgcn_s_getreg((3 << 11) | 20) & 0xFu; }
#define XB_SPIN(cond, bar) do { unsigned _sp = 0; while (cond) { __builtin_amdgcn_s_sleep(1); \
    if ((++_sp & 255u) == 0u) { if (xb_ld(&(bar)[XB_TMO])) break; if (_sp > XB_SPIN_CAP) { atomicAdd(&(bar)[XB_TMO], 1u); break; } } } } while (0)

struct XcdBarrier {
    unsigned* bar; unsigned x;
    volatile LAS unsigned* st;
};

__device__ __forceinline__ XcdBarrier xcd_barrier_post(unsigned* bar, volatile LAS unsigned* st, bool leader) {
    XcdBarrier b; b.bar = bar; b.x = xb_xcc_id(); b.st = st;
    if (leader) (void)xb_add(&bar[XB_XCNT(b.x)], 1u);
    return b;
}
__device__ __forceinline__ void xcd_barrier_complete(unsigned* bar, unsigned x, unsigned& nloc, unsigned& nx) {
    const unsigned G = gridDim.x * gridDim.y * gridDim.z;
    unsigned sum, cnt, mine, sp = 0u;
    for (;;) {
        sum = 0u; cnt = 0u; mine = 0u;
#pragma unroll
        for (unsigned j = 0; j < 16; ++j) { const unsigned c = xb_ld(&bar[XB_XCNT(j)]); sum += c; cnt += (c > 0u) ? 1u : 0u; mine = (j == x) ? c : mine; }
        if (sum == G) break;
        __builtin_amdgcn_s_sleep(1);
        if ((++sp & 255u) == 0u) { if (xb_ld(&bar[XB_TMO])) break; if (sp > XB_SPIN_CAP) { atomicAdd(&bar[XB_TMO], 1u); break; } }
    }
    nloc = mine > 0u ? mine : 1u; nx = cnt > 0u ? cnt : 1u;
}

__device__ __forceinline__ void xcd_barrier(const XcdBarrier& b, bool leader) {
    asm volatile("s_waitcnt vmcnt(0)" ::: "memory");
    __syncthreads();
    if (leader) {
        unsigned* bar = b.bar;
        __builtin_amdgcn_s_waitcnt(0);
        unsigned nloc = b.st[0], nx = b.st[1];
        if (nloc == 0u) { xcd_barrier_complete(bar, b.x, nloc, nx); b.st[0] = nloc; b.st[1] = nx; }
        const unsigned old = xb_add(&bar[XB_XSUB(b.x)], 1u);
        const unsigned gen = old / nloc;
        if (old + 1u == (gen + 1u) * nloc) {
            __builtin_amdgcn_fence(__ATOMIC_RELEASE, "agent");
            asm volatile("s_waitcnt vmcnt(0)" ::: "memory");
            const unsigned og = xb_add(&bar[XB_TOP], 1u);
            const unsigned tg = og / nx;
            if (og + 1u == (tg + 1u) * nx) xb_add(&bar[XB_TOPGEN], 1u);
            else XB_SPIN(xb_ld(&bar[XB_TOPGEN]) == tg, bar);
            __builtin_amdgcn_fence(__ATOMIC_ACQUIRE, "agent");
            xb_add(&bar[XB_XGEN(b.x)], 1u);
            asm volatile("s_waitcnt vmcnt(0)" ::: "memory");
        } else {
            XB_SPIN(xb_ld(&bar[XB_XGEN(b.x)]) == gen, bar);
            __builtin_amdgcn_fence(__ATOMIC_ACQUIRE, "agent");
            asm volatile("s_waitcnt vmcnt(0)" ::: "memory");
        }
    }
    __syncthreads();
}

constexpr int NWAVES = 8;
constexpr int T = 16384, SEQ = 2048, NBATCH = 8, DM = 1024, DFF = 2816, INW = 6744, INWP = 6912;
constexpr float EPS = 1e-6f;
constexpr size_t MiB = 1u << 20;
constexpr size_t WS_CTL = 0, CTL_ZERO_BYTES = 1 * MiB;
constexpr size_t WS_WGU = 1 * MiB;
constexpr size_t WS_WDN = 12 * MiB;
constexpr size_t WS_WPA = WS_WDN + 5632 * 1024;
constexpr size_t WS_WPB = WS_WPA + 2 * MiB;
constexpr size_t WS_WOUT = WS_WPB + 2 * MiB;
constexpr size_t WS_WQI = WS_WOUT + 2 * MiB;
constexpr size_t WS_WUKT = WS_WQI + 768 * 1024;
constexpr size_t WS_WUVT = WS_WUKT + 512 * 1024;
constexpr size_t WS_KIDX = 25 * MiB + 256 * 1024;
constexpr size_t WS_WIDX = WS_KIDX + 2 * MiB;
constexpr size_t WS_BETA = WS_WIDX + 512 * 1024;
constexpr size_t WS_GG = WS_BETA + 512 * 1024;
constexpr size_t WS_PQ = 29 * MiB;
constexpr size_t WS_PQKV = 45 * MiB;
constexpr size_t WS_PZ = 141 * MiB;
constexpr size_t WS_PG = 173 * MiB;
constexpr size_t WS_PS32 = 237 * MiB;
constexpr size_t WS_END = 253 * MiB;
constexpr size_t WS_QI = WS_PQKV;
constexpr size_t WS_SEL = WS_QI + 48 * MiB;
constexpr size_t WS_OA = WS_SEL + 16 * MiB;
constexpr size_t WS_ACT = WS_PQKV;
constexpr size_t DO_H = 0;
constexpr size_t DO_WIN = 32 * MiB;
constexpr size_t DO_HALO = 0;
constexpr size_t DO_WDEC = 8 * MiB;
constexpr size_t DO_QKG = 40 * MiB;
constexpr size_t DO_ATAIL = 56 * MiB;

constexpr int LDS_BYTES = 147456;
constexpr int RING_BYTES = 139264;
constexpr int MISC_OFF = RING_BYTES + 320;

#define MFMA16(a, b, c) __builtin_amdgcn_mfma_f32_16x16x32_f16((a), (b), (c), 0, 0, 0)
#define LDS_WAIT() asm volatile("s_waitcnt lgkmcnt(0)" ::: "memory")
#define VM_WAIT() asm volatile("s_waitcnt vmcnt(0)" ::: "memory")

__device__ __forceinline__ float wave_sum(float v) {
#pragma unroll
    for (int o = 1; o < 64; o <<= 1) v += __shfl_xor(v, o);
    return v;
}
__device__ __forceinline__ float half_sum(float v) {
#pragma unroll
    for (int o = 1; o < 32; o <<= 1) v += __shfl_xor(v, o);
    return v;
}

__device__ __forceinline__ int lane_id_asm() { int l; asm volatile("v_mbcnt_lo_u32_b32 %0, -1, 0\n\tv_mbcnt_hi_u32_b32 %0, -1, %0" : "=v"(l)); return l; }
struct Ctx {
    LAS unsigned char* lds;
    int tid, lane, wave, G, bid;
    const float* const* in; float* out; unsigned char* ws;
};
#define WSP(T_, off) ((T_*)(C.ws + (off)))
#define DOP(T_, off) ((T_*)((unsigned char*)C.out + (off)))

struct Src { const float* p; int ld; };
struct MapId { const float* W; int N; __device__ __forceinline__ Src operator()(int n) const { return Src{W + n, N}; } };
struct MapWin { const float* W; __device__ __forceinline__ Src operator()(int n) const {
    int c;
    if (n < 512) c = n; else if (n < 1536) c = 584 + (n - 512); else if (n < 2560) c = 1608 + (n - 1536); else if (n < 3584) c = 2632 + (n - 2560);
    else if (n < 4608) c = 3672 + (n - 3584); else if (n < 5632) c = 4696 + (n - 4608); else if (n < 6656) c = 5720 + (n - 5632);
    else { const int q = n - 6656; if (q < 64) c = 512 + q; else if (q < 72) c = 576 + (q - 64); else if (q < 80) c = 3656 + (q - 72); else if (q < 88) c = 3664 + (q - 80); else c = -1; }
    return Src{c >= 0 ? W + c : nullptr, INW}; } };
struct MapGU { const float* Wg; const float* Wu; __device__ __forceinline__ Src operator()(int n) const { const int t = n >> 8, w = n & 255; return (w < 128) ? Src{Wg + 128 * t + w, DFF} : Src{Wu + 128 * t + (w - 128), DFF}; } };
struct MapQI { const float* Wq; const float* Wi; __device__ __forceinline__ Src operator()(int n) const { return (n < 1024) ? Src{Wq + n, 1024} : Src{Wi + (n - 1024), 512}; } };

template <class Map>
__device__ __forceinline__ void tr_item(const Map& map, int K, h16s* WT, LAS float* scr, int item, int nblk, int lane) {
    const int kb = item / nblk, nb = item % nblk, k0 = 64 * kb, n0 = 32 * nb;
    const Src s = map(n0 + (lane & 31));
#pragma unroll 8
    for (int i = 0; i < 32; ++i) { const int kk = 2 * i + (lane >> 5); scr[kk * 33 + (lane & 31)] = s.p ? s.p[(size_t)(k0 + kk) * s.ld] : 0.f; }
    LDS_WAIT(); asm volatile("" ::: "memory");
    const int c = lane & 7;
#pragma unroll
    for (int j = 0; j < 4; ++j) { const int n = (lane >> 3) + 8 * j; const LAS float* q = scr + (8 * c) * 33 + n;
        u32x4 o; o.x = pkh(q[0 * 33], q[1 * 33]); o.y = pkh(q[2 * 33], q[3 * 33]); o.z = pkh(q[4 * 33], q[5 * 33]); o.w = pkh(q[6 * 33], q[7 * 33]);
        *(u32x4*)(WT + (size_t)(n0 + n) * K + k0 + 8 * c) = o; }
    LDS_WAIT(); asm volatile("" ::: "memory");
}
__device__ __forceinline__ void rms_row_f16(const float* xrow, const float* g, h16s* orow, int lane) {
    const f32x4* xr = (const f32x4*)xrow + lane; const f32x4* gr = (const f32x4*)g + lane;
    f32x4 v[4]; float s = 0.f;
#pragma unroll
    for (int j = 0; j < 4; ++j) { v[j] = xr[64 * j]; s += (v[j].x * v[j].x + v[j].y * v[j].y) + (v[j].z * v[j].z + v[j].w * v[j].w); }
    const float r = rsqrtf(wave_sum(s) * (1.f / 1024.f) + EPS);
    u32x2* o8 = (u32x2*)orow + lane;
#pragma unroll
    for (int j = 0; j < 4; ++j) { const f32x4 gg = gr[64 * j]; u32x2 w; w.x = pkh(v[j].x * r * gg.x, v[j].y * r * gg.y); w.y = pkh(v[j].z * r * gg.z, v[j].w * r * gg.w); o8[64 * j] = w; }
}
__device__ __forceinline__ void p0_prologue(Ctx& C) {
    LAS float* scr = (LAS float*)(C.lds + C.wave * 16384);
    const int gw = C.bid * NWAVES + C.wave, NGW = C.G * NWAVES;
    constexpr int I_IN = 16 * (INWP / 32), I_GU = 16 * (5632 / 32), I_DN = 44 * 32, I_SQ = 16 * 32, I_QI = 4 * 48;
    constexpr int I_UK = 16 * 8, I_UV = 16 * 8;
    constexpr int NITEMS = I_IN + I_GU + I_DN + 3 * I_SQ + I_QI + I_UK + I_UV;
    for (int it = gw; it < NITEMS; it += NGW) {
        int r = it;
        if (r < I_IN) { tr_item(MapWin{C.in[2]}, 1024, DOP(h16s, DO_WIN), scr, r, INWP / 32, C.lane); continue; } r -= I_IN;
        if (r < I_GU) { tr_item(MapGU{C.in[19], C.in[20]}, 1024, WSP(h16s, WS_WGU), scr, r, 5632 / 32, C.lane); continue; } r -= I_GU;
        if (r < I_DN) { tr_item(MapId{C.in[21], 1024}, 2816, WSP(h16s, WS_WDN), scr, r, 32, C.lane); continue; } r -= I_DN;
        if (r < I_SQ) { tr_item(MapId{C.in[11], 1024}, 1024, WSP(h16s, WS_WPA), scr, r, 32, C.lane); continue; } r -= I_SQ;
        if (r < I_SQ) { tr_item(MapId{C.in[16], 1024}, 1024, WSP(h16s, WS_WPB), scr, r, 32, C.lane); continue; } r -= I_SQ;
        if (r < I_SQ) { tr_item(MapId{C.in[17], 1024}, 1024, WSP(h16s, WS_WOUT), scr, r, 32, C.lane); continue; } r -= I_SQ;
        if (r < I_QI) { tr_item(MapQI{C.in[5], C.in[8]}, 256, WSP(h16s, WS_WQI), scr, r, 48, C.lane); continue; } r -= I_QI;
        if (r < I_UK) { const int h = r >> 3; tr_item(MapId{C.in[6] + (size_t)h * 64 * 256, 256}, 64, WSP(h16s, WS_WUKT) + (size_t)h * 256 * 64, scr, r & 7, 8, C.lane); continue; } r -= I_UK;
        { const int h = r >> 3; tr_item(MapId{C.in[7] + (size_t)h * 256 * 64, 64}, 256, WSP(h16s, WS_WUVT) + (size_t)h * 64 * 256, scr, r & 7, 2, C.lane); }
    }
    for (int m = gw; m < T; m += NGW) rms_row_f16(C.in[0] + (size_t)m * DM, C.in[1], DOP(h16s, DO_H) + (size_t)m * DM, C.lane);
}

__device__ __forceinline__ void p2_prep(Ctx& C) {
    const int gw = C.bid * NWAVES + C.wave, NGW = C.G * NWAVES, lane = C.lane;
    const float* cqg = C.in[3]; const float* ckvg = C.in[4]; const float* lng = C.in[9]; const float* lnb = C.in[10]; const float* alog = C.in[13]; const float* dtb = C.in[14];
    for (int m = gw; m < T; m += NGW) {
        { u32x4* p = WSP(u32x4, WS_PQ) + (size_t)m * 64 + lane; const u32x4 w = *p; const float* g = (lane < 32 ? cqg : ckvg) + (lane & 31) * 8;
          const f32x2 a = unpkh(w.x), b = unpkh(w.y), c = unpkh(w.z), d = unpkh(w.w);
          const float ss = half_sum((a[0] * a[0] + a[1] * a[1]) + (b[0] * b[0] + b[1] * b[1]) + (c[0] * c[0] + c[1] * c[1]) + (d[0] * d[0] + d[1] * d[1]));
          const float r = rsqrtf(ss * (1.f / 256.f) + EPS); const f32x4 g0 = *(const f32x4*)g, g1 = *(const f32x4*)(g + 4);
          u32x4 o; o.x = pkh(a[0] * r * g0.x, a[1] * r * g0.y); o.y = pkh(b[0] * r * g0.z, b[1] * r * g0.w); o.z = pkh(c[0] * r * g1.x, c[1] * r * g1.y); o.w = pkh(d[0] * r * g1.z, d[1] * r * g1.w); *p = o; }
        const float* ps = WSP(float, WS_PS32) + (size_t)m * 256;
        { const float x = ps[lane]; const float mu = wave_sum(x) * (1.f / 64.f); const float xc = x - mu; const float var = wave_sum(xc * xc) * (1.f / 64.f);
          const float y = xc * rsqrtf(var + EPS) * lng[lane] + lnb[lane]; WSP(h16s, WS_KIDX)[(size_t)m * 64 + lane] = f2h(y); }
        if (lane < 8) {
            WSP(float, WS_WIDX)[(size_t)m * 8 + lane] = ps[64 + lane] * (0.35355339059327373f * 0.125f);
            WSP(float, WS_BETA)[(size_t)m * 8 + lane] = 1.f / (1.f + expf(-ps[72 + lane]));
            const float xa = ps[80 + lane] + dtb[lane]; const float sp = xa > 20.f ? xa : log1pf(expf(xa));
            WSP(float, WS_GG)[(size_t)m * 8 + lane] = -expf(alog[lane]) * sp;
        }
        const int t = m & (SEQ - 1), tc = t & 63, c = t >> 6;
        if (tc >= 61 && c < 31) {
            const u32x4* src = WSP(u32x4, WS_PQKV) + (size_t)m * 384; u32x4* dst = DOP(u32x4, DO_HALO) + ((size_t)((m >> 11) * 32 + c + 1) * 3 + (tc - 61)) * 384;
#pragma unroll
            for (int i = 0; i < 6; ++i) dst[i * 64 + lane] = src[i * 64 + lane];
        }
    }
}

__device__ __forceinline__ void p3_conv_inplace(Ctx& C) {
    LAS float* tile = (LAS float*)C.lds;
    const float* convw = C.in[12];
    const int tid = C.tid;
    for (int u = C.bid; u < NBATCH * 32 * 8 * 3; u += C.G) {
        const int part = u % 3, h = (u / 3) & 7, c = (u / 24) & 31, b = u / (24 * 32);
        const size_t m0 = (size_t)b * SEQ + c * 64; const int colb = part * 1024 + h * 128;
        for (int i = tid; i < 67 * 16; i += 512) { const int row = i >> 4, ch = i & 15; u32x4 w = (u32x4){0u, 0u, 0u, 0u};
            if (row >= 3) w = *(const u32x4*)(WSP(h16s, WS_PQKV) + (m0 + row - 3) * 3072 + colb + ch * 8);
            else if (c > 0) w = *(const u32x4*)(DOP(h16s, DO_HALO) + ((size_t)(b * 32 + c) * 3 + row) * 3072 + colb + ch * 8);
            const f32x2 a = unpkh(w.x), bb = unpkh(w.y), cc = unpkh(w.z), d = unpkh(w.w); LAS float* tp = tile + row * 128 + ch * 8;
            *(LAS f32x4*)tp = (f32x4){a[0], a[1], bb[0], bb[1]}; *(LAS f32x4*)(tp + 4) = (f32x4){cc[0], cc[1], d[0], d[1]}; }
        __syncthreads();
        const int r = tid >> 3, cg = tid & 7; float o[16]; float ss = 0.f;
#pragma unroll
        for (int i = 0; i < 16; ++i) { const int col = cg * 16 + i; float a = 0.f;
#pragma unroll
            for (int j = 0; j < 4; ++j) a += convw[j * 3072 + colb + col] * tile[(r + j) * 128 + col];
            a = a / (1.f + expf(-a)); o[i] = a; ss += a * a; }
        if (part < 2) { ss += __shfl_xor(ss, 1); ss += __shfl_xor(ss, 2); ss += __shfl_xor(ss, 4);
            const float sc = rsqrtf(ss + EPS) * (part == 0 ? 0.08838834764831845f : 1.f);
#pragma unroll
            for (int i = 0; i < 16; ++i) o[i] *= sc; }
        u32x4 w0, w1; w0.x = pkh(o[0], o[1]); w0.y = pkh(o[2], o[3]); w0.z = pkh(o[4], o[5]); w0.w = pkh(o[6], o[7]); w1.x = pkh(o[8], o[9]); w1.y = pkh(o[10], o[11]); w1.z = pkh(o[12], o[13]); w1.w = pkh(o[14], o[15]);
        u32x4* dst = (u32x4*)(WSP(h16s, WS_PQKV) + (m0 + r) * 3072 + colb + cg * 16); dst[0] = w0; dst[1] = w1;
        __syncthreads();
    }
}
__device__ __forceinline__ void p4_scan_naive(Ctx& C) {
    if (C.wave != 0) return;
    const int lane = C.lane;
    LAS u32x4* kq = (LAS u32x4*)C.lds;
    for (int u = C.bid; u < 256; u += C.G) {
    const int bh = u >> 2, b = bh >> 3, h = bh & 7, j = (u & 3) * 32 + (lane & 31), dh = lane >> 5;
    float S[64];
#pragma unroll
    for (int d = 0; d < 64; ++d) S[d] = 0.f;
    h16s* base = WSP(h16s, WS_PQKV) + (size_t)b * SEQ * 3072;
    for (int t0 = 0; t0 < SEQ; t0 += 16) {
#pragma unroll
        for (int i = 0; i < 8; ++i) { const int idx = i * 64 + lane, row = idx >> 5, ch = idx & 31;
            kq[idx] = *(const u32x4*)(base + (size_t)(t0 + row) * 3072 + (ch < 16 ? h * 128 + ch * 8 : 1024 + h * 128 + (ch - 16) * 8)); }
        LDS_WAIT(); asm volatile("" ::: "memory");
#pragma unroll 1
        for (int tt = 0; tt < 16; ++tt) {
            const size_t m = (size_t)b * SEQ + t0 + tt; h16s* vp = base + (size_t)(t0 + tt) * 3072 + 2048 + h * 128 + j;
            const float v = h2f(*vp), beta = WSP(float, WS_BETA)[m * 8 + h], a = expf(WSP(float, WS_GG)[m * 8 + h]);
            float dot = 0.f;
#pragma unroll
            for (int c = 0; c < 8; ++c) { const h16x8 kv = __builtin_bit_cast(h16x8, kq[tt * 32 + 16 + dh * 8 + c]);
#pragma unroll
                for (int e = 0; e < 8; ++e) dot += S[c * 8 + e] * (float)kv[e]; }
            dot += __shfl_xor(dot, 32);
            const float uu = beta * (v - a * dot); float o = 0.f;
#pragma unroll
            for (int c = 0; c < 8; ++c) { const h16x8 kv = __builtin_bit_cast(h16x8, kq[tt * 32 + 16 + dh * 8 + c]); const h16x8 qv = __builtin_bit_cast(h16x8, kq[tt * 32 + dh * 8 + c]);
#pragma unroll
                for (int e = 0; e < 8; ++e) { const float s = a * S[c * 8 + e] + (float)kv[e] * uu; S[c * 8 + e] = s; o += s * (float)qv[e]; } }
            o += __shfl_xor(o, 32);
            if (dh == 0) *vp = f2h(o);
        }
        asm volatile("" ::: "memory");
    }
    }
}
__device__ __forceinline__ void p5_gated_norm(Ctx& C) {
    const int gw = C.bid * NWAVES + C.wave, NGW = C.G * NWAVES, lane = C.lane; const float* og = C.in[15];
    for (int m = gw; m < T; m += NGW) {
#pragma unroll
        for (int p = 0; p < 2; ++p) {
            const int col = p * 512 + lane * 8;
            const u32x4 w = *(const u32x4*)(WSP(h16s, WS_PQKV) + (size_t)m * 3072 + 2048 + col); u32x4* zp = (u32x4*)(WSP(h16s, WS_PZ) + (size_t)m * 1024 + col); const u32x4 z = *zp;
            const f32x2 a = unpkh(w.x), b = unpkh(w.y), c = unpkh(w.z), d = unpkh(w.w);
            float ss = (a[0] * a[0] + a[1] * a[1]) + (b[0] * b[0] + b[1] * b[1]) + (c[0] * c[0] + c[1] * c[1]) + (d[0] * d[0] + d[1] * d[1]);
            ss += __shfl_xor(ss, 1); ss += __shfl_xor(ss, 2); ss += __shfl_xor(ss, 4); ss += __shfl_xor(ss, 8);
            const float r = rsqrtf(ss * (1.f / 128.f) + EPS); const float* g = og + (col & 127); const f32x4 g0 = *(const f32x4*)g, g1 = *(const f32x4*)(g + 4);
            const f32x2 z0 = unpkh(z.x), z1 = unpkh(z.y), z2 = unpkh(z.z), z3 = unpkh(z.w);
            u32x4 o; o.x = pkh(a[0] * r * g0.x * siluf_(z0[0]), a[1] * r * g0.y * siluf_(z0[1])); o.y = pkh(b[0] * r * g0.z * siluf_(z1[0]), b[1] * r * g0.w * siluf_(z1[1]));
            o.z = pkh(c[0] * r * g1.x * siluf_(z2[0]), c[1] * r * g1.y * siluf_(z2[1])); o.w = pkh(d[0] * r * g1.z * siluf_(z3[0]), d[1] * r * g1.w * siluf_(z3[1])); *zp = o;
        }
    }
}


__device__ __forceinline__ void p3_gdn_prep(Ctx& C) {
    const int tid = C.tid, lane = C.lane, wave = C.wave, l15 = lane & 15, g = lane >> 4;
    LAS unsigned char* L = C.lds;
    LAS h16s* RAW = (LAS h16s*)L;
    LAS unsigned char* QS = L + 52224; LAS unsigned char* KS = QS + 17408; LAS unsigned char* VS = KS + 17408;
    LAS float* AM = (LAS float*)(L + 104448);
    LAS float* GV = (LAS float*)(L + 121856);
    LAS unsigned char* STG = L;
    LAS unsigned char* QKS = L + 17408;
    const float* convw = C.in[12];
    h16s* PQKV = WSP(h16s, WS_PQKV);
    for (int u = C.bid; u < 2048; u += C.G) {
        const int h = u & 7, c = (u >> 3) & 31, b = u >> 8; const size_t m0 = (size_t)b * SEQ + c * 64;
        for (int i = tid; i < 3 * 67 * 16; i += 512) { const int part = i / (67 * 16), rem = i - part * (67 * 16), row = rem >> 4, ch = rem & 15; const int colb = part * 1024 + h * 128; u32x4 w = (u32x4){0u, 0u, 0u, 0u};
            if (row >= 3) w = *(const u32x4*)(PQKV + (m0 + row - 3) * 3072 + colb + ch * 8);
            else if (c > 0) w = *(const u32x4*)(DOP(h16s, DO_HALO) + ((size_t)(b * 32 + c) * 3 + row) * 3072 + colb + ch * 8);
            *(LAS u32x4*)(RAW + (part * 67 + row) * 128 + ch * 8) = w; }
        __syncthreads();
        { const int r = tid >> 3, cg = tid & 7;
#pragma unroll 1
          for (int part = 0; part < 3; ++part) { float o[16]; float ss = 0.f; const int colb = part * 1024 + h * 128;
#pragma unroll
            for (int i = 0; i < 16; ++i) { const int col = cg * 16 + i; float a = 0.f;
#pragma unroll
                for (int j = 0; j < 4; ++j) a += convw[j * 3072 + colb + col] * h2f(RAW[(part * 67 + r + j) * 128 + col]);
                a = a / (1.f + expf(-a)); o[i] = a; ss += a * a; }
            if (part < 2) { ss += __shfl_xor(ss, 1); ss += __shfl_xor(ss, 2); ss += __shfl_xor(ss, 4);
                const float sc = rsqrtf(ss + EPS) * (part == 0 ? 0.08838834764831845f : 1.f);
#pragma unroll
                for (int i = 0; i < 16; ++i) o[i] *= sc; }
            u32x4 w0, w1; w0.x = pkh(o[0], o[1]); w0.y = pkh(o[2], o[3]); w0.z = pkh(o[4], o[5]); w0.w = pkh(o[6], o[7]); w1.x = pkh(o[8], o[9]); w1.y = pkh(o[10], o[11]); w1.z = pkh(o[12], o[13]); w1.w = pkh(o[14], o[15]);
            LAS unsigned char* tp = (part == 0 ? QS : part == 1 ? KS : VS) + r * 272 + cg * 32; *(LAS u32x4*)tp = w0; *(LAS u32x4*)(tp + 16) = w1; } }
        if (wave == 0) { const float gi = WSP(float, WS_GG)[(m0 + lane) * 8 + h], bi = WSP(float, WS_BETA)[(m0 + lane) * 8 + h]; float G = gi;
#pragma unroll
            for (int o = 1; o < 64; o <<= 1) { const float tv = __shfl_up(G, o); if (lane >= o) G += tv; }
            const float Gl = __shfl(G, 63); GV[lane] = G; GV[64 + lane] = bi; GV[128 + lane] = expf(G); GV[192 + lane] = expf(Gl - G);
            if (lane == 63) DOP(float, DO_ATAIL)[u] = expf(G); }
        __syncthreads();
        if (wave < 4) { const int bi = wave;
            for (int bj = 0; bj <= bi; ++bj) { f32x4 acc = (f32x4){0.f, 0.f, 0.f, 0.f};
#pragma unroll
                for (int ks = 0; ks < 4; ++ks) acc = MFMA16(*(const LAS h16x8*)(KS + (16 * bi + l15) * 272 + (32 * ks + 8 * g) * 2), *(const LAS h16x8*)(KS + (16 * bj + l15) * 272 + (32 * ks + 8 * g) * 2), acc);
                const int j = 16 * bj + l15; const float Gj = GV[j];
#pragma unroll
                for (int r = 0; r < 4; ++r) { const int i = 16 * bi + 4 * g + r; AM[i * 68 + j] = (i > j) ? GV[64 + i] * acc[r] * expf(GV[i] - Gj) : 0.f; } }
        } else { const int bi = wave - 4;
            for (int bj = 0; bj < 4; ++bj) { f32x4 acc = (f32x4){0.f, 0.f, 0.f, 0.f};
                if (bj <= bi) {
#pragma unroll
                    for (int ks = 0; ks < 4; ++ks) acc = MFMA16(*(const LAS h16x8*)(QS + (16 * bi + l15) * 272 + (32 * ks + 8 * g) * 2), *(const LAS h16x8*)(KS + (16 * bj + l15) * 272 + (32 * ks + 8 * g) * 2), acc); }
                const int j = 16 * bj + l15; const float Gj = GV[j];
#pragma unroll
                for (int r = 0; r < 4; ++r) { const int i = 16 * bi + 4 * g + r; *(LAS h16s*)(QKS + i * 144 + j * 2) = f2h((i >= j) ? acc[r] * expf(GV[i] - Gj) : 0.f); } }
        }
        __syncthreads();
        if (tid < 256) {
            const int cc = tid, isk = cc >> 7, col = cc & 127; const LAS unsigned char* tile = isk ? KS : VS;
            float x[64];
            float dep = 0.f;
#pragma unroll
            for (int i = 0; i < 64; ++i) {
                int rowoff = i * 272; asm volatile("" : "+v"(rowoff), "+v"(dep));
                const LAS unsigned char* arow = (const LAS unsigned char*)AM + rowoff;
                float s = GV[64 + i] * (isk ? GV[128 + i] : 1.f) * h2f(*(const LAS h16s*)(tile + i * 272 + col * 2));
#pragma unroll
                for (int m4 = 0; m4 < (i + 3) / 4; ++m4) { const f32x4 a = *(const LAS f32x4*)(arow + 16 * m4);
#pragma unroll
                    for (int e = 0; e < 4; ++e) if (4 * m4 + e < i) s -= a[e] * x[4 * m4 + e]; }
                x[i] = s; dep = s; }
            if (!isk) { const int q4 = col >> 5, vl = col & 31;
#pragma unroll
                for (int th = 0; th < 2; ++th) { u32x4* dst = (u32x4*)(PQKV + (m0 + 2 * vl + th) * 3072 + 2048 + h * 128 + 32 * q4);
#pragma unroll
                    for (int q = 0; q < 4; ++q) { u32x4 w; w.x = pkh(x[32 * th + 8 * q], x[32 * th + 8 * q + 1]); w.y = pkh(x[32 * th + 8 * q + 2], x[32 * th + 8 * q + 3]); w.z = pkh(x[32 * th + 8 * q + 4], x[32 * th + 8 * q + 5]); w.w = pkh(x[32 * th + 8 * q + 6], x[32 * th + 8 * q + 7]); dst[q] = w; } }
            } else {
#pragma unroll
                for (int i = 0; i < 64; ++i) *(LAS h16s*)(STG + i * 272 + col * 2) = f2h(x[i]); }
        } else { const int tt = tid - 256;
            { const int r = tt >> 2, cq = tt & 3; const float eg = GV[128 + r]; u32x4* dst = (u32x4*)(PQKV + (m0 + r) * 3072 + h * 128 + 32 * cq);
#pragma unroll
              for (int q = 0; q < 4; ++q) { const u32x4 w = *(const LAS u32x4*)(QS + r * 272 + cq * 64 + q * 16); const f32x2 a = unpkh(w.x), bb = unpkh(w.y), cc = unpkh(w.z), d = unpkh(w.w);
                  u32x4 o; o.x = pkh(a[0] * eg, a[1] * eg); o.y = pkh(bb[0] * eg, bb[1] * eg); o.z = pkh(cc[0] * eg, cc[1] * eg); o.w = pkh(d[0] * eg, d[1] * eg); dst[q] = o; } }
            { const int d = tt & 127, th = tt >> 7; u32x4* dst = (u32x4*)(PQKV + (m0 + (d >> 1)) * 3072 + 1024 + h * 128 + (d & 1) * 64 + 32 * th);
#pragma unroll
              for (int q = 0; q < 4; ++q) { float v[8];
#pragma unroll
                  for (int e = 0; e < 8; ++e) { const int t = 32 * th + 8 * q + e; v[e] = h2f(*(const LAS h16s*)(KS + t * 272 + d * 2)) * GV[192 + t]; }
                  u32x4 o; o.x = pkh(v[0], v[1]); o.y = pkh(v[2], v[3]); o.z = pkh(v[4], v[5]); o.w = pkh(v[6], v[7]); dst[q] = o; } }
            { const int row = tt >> 2, seg = tt & 3; u32x4* dst = (u32x4*)(DOP(h16s, DO_QKG) + ((size_t)u * 64 + row) * 64 + seg * 16);
              dst[0] = *(const LAS u32x4*)(QKS + row * 144 + seg * 32); dst[1] = *(const LAS u32x4*)(QKS + row * 144 + seg * 32 + 16); }
        }
        __syncthreads();
        { const int row = tid >> 3, seg = tid & 7; u32x4* dst = (u32x4*)(DOP(h16s, DO_WDEC) + ((size_t)u * 64 + row) * 128 + seg * 16);
          dst[0] = *(const LAS u32x4*)(STG + row * 272 + seg * 32); dst[1] = *(const LAS u32x4*)(STG + row * 272 + seg * 32 + 16); }
        __syncthreads();
    }
}
#define MFMA32(a, b, c) __builtin_amdgcn_mfma_f32_32x32x16_f16((a), (b), (c), 0, 0, 0)
__device__ __forceinline__ void p4_gdn_scan(Ctx& C) {
    const int lane = C.lane, wave = C.wave, l31 = lane & 31, hi = lane >> 5;
    LAS unsigned char* ST = C.lds;
    LAS unsigned char* UT = C.lds + 8704;
    const h16s* PQKV = WSP(h16s, WS_PQKV); const h16s* WDEC = DOP(h16s, DO_WDEC); const h16s* QKG = DOP(h16s, DO_QKG); const float* ATAIL = DOP(float, DO_ATAIL);
    for (int u = C.bid; u < 256; u += C.G) {
        const int q4 = u & 3, h = (u >> 2) & 7, b = u >> 5;
        for (int i = C.tid; i < 8704 / 4; i += 512) ((LAS unsigned*)ST)[i] = 0u;
        f32x16 S;
#pragma unroll
        for (int r = 0; r < 16; ++r) S[r] = 0.f;
        __syncthreads();
#pragma unroll 1
        for (int c = 0; c < 32; ++c) { const size_t uc = (size_t)(b * 32 + c) * 8 + h, m0c = (size_t)b * SEQ + c * 64;
            f32x16 acc;
#pragma unroll
            for (int r = 0; r < 16; ++r) acc[r] = 0.f;
            const int tt = wave & 1;
            if (wave < 4) { const h16s* ap = (wave < 2) ? WDEC + (uc * 64 + 32 * tt + l31) * 128 + 8 * hi : PQKV + (m0c + 32 * tt + l31) * 3072 + h * 128 + 8 * hi;
#pragma unroll
                for (int ks = 0; ks < 8; ++ks) acc = MFMA32(*(const h16x8*)(ap + 16 * ks), *(const LAS h16x8*)(ST + l31 * 272 + (16 * ks + 8 * hi) * 2), acc);
                if (wave < 2) { const h16s* ub = PQKV + (m0c + 2 * l31 + tt) * 3072 + 2048 + h * 128 + 32 * q4 + 4 * hi;
#pragma unroll
                    for (int rg = 0; rg < 4; ++rg) { const u32x2 w = *(const u32x2*)(ub + 8 * rg); const f32x2 a = unpkh(w.x), bb = unpkh(w.y);
                        u32x2 o; o.x = pkh(a[0] - acc[4 * rg], a[1] - acc[4 * rg + 1]); o.y = pkh(bb[0] - acc[4 * rg + 2], bb[1] - acc[4 * rg + 3]);
                        *(LAS u32x2*)(UT + l31 * 144 + (32 * tt + 8 * rg + 4 * hi) * 2) = o; } } }
            LDS_WAIT(); __syncthreads();
            if (wave >= 2 && wave < 4) { const h16s* ap = QKG + (uc * 64 + 32 * tt + l31) * 64 + 8 * hi;
#pragma unroll
                for (int ks = 0; ks < 4; ++ks) acc = MFMA32(*(const h16x8*)(ap + 16 * ks), *(const LAS h16x8*)(UT + l31 * 144 + (16 * ks + 8 * hi) * 2), acc);
                h16s* op = WSP(h16s, WS_PQKV) + (m0c + 32 * tt + 4 * hi) * 3072 + 2048 + h * 128 + 32 * q4 + l31;
#pragma unroll
                for (int r = 0; r < 16; ++r) op[(size_t)(8 * (r >> 2) + (r & 3)) * 3072] = f2h(acc[r]);
            } else if (wave >= 4) { const int dt = wave - 4, d = 32 * dt + l31; const float at = ATAIL[uc];
                const h16s* ap = PQKV + (m0c + (d >> 1)) * 3072 + 1024 + h * 128 + (d & 1) * 64 + 8 * hi;
#pragma unroll
                for (int r = 0; r < 16; ++r) S[r] *= at;
#pragma unroll
                for (int ks = 0; ks < 4; ++ks) S = MFMA32(*(const h16x8*)(ap + 16 * ks), *(const LAS h16x8*)(UT + l31 * 144 + (16 * ks + 8 * hi) * 2), S);
#pragma unroll
                for (int rg = 0; rg < 4; ++rg) { u32x2 o; o.x = pkh(S[4 * rg], S[4 * rg + 1]); o.y = pkh(S[4 * rg + 2], S[4 * rg + 3]); *(LAS u32x2*)(ST + l31 * 272 + (32 * dt + 8 * rg + 4 * hi) * 2) = o; } }
            LDS_WAIT(); __syncthreads();
        }
    }
}

__device__ __forceinline__ unsigned sortable(float f) { unsigned u = __float_as_uint(f + 0.f); return (u & 0x80000000u) ? ~u : (u | 0x80000000u); }
__device__ __forceinline__ void p7_topk_naive(Ctx& C) {
    const int gw = C.bid * NWAVES + C.wave, NGW = C.G * NWAVES, lane = C.lane;
    LAS float* sc = (LAS float*)(C.lds + C.wave * 9216);
    LAS u32x4* qs = (LAS u32x4*)(C.lds + C.wave * 9216 + 8192);
    for (int m = gw; m < T; m += NGW) {
        const int t = m & (SEQ - 1), b = m >> 11, n = t + 1; int* sel = WSP(int, WS_SEL) + (size_t)m * 256;
        if (n <= 256) { for (int i = lane; i < 256; i += 64) sel[i] = i < n ? i : 0; continue; }
        qs[lane] = *(const u32x4*)(WSP(h16s, WS_QI) + (size_t)m * 1536 + 1024 + lane * 8);
        float wq[8];
#pragma unroll
        for (int hh = 0; hh < 8; ++hh) wq[hh] = WSP(float, WS_WIDX)[(size_t)m * 8 + hh];
        LDS_WAIT(); asm volatile("" ::: "memory");
        const int nj = (n + 63) >> 6;
        for (int jj = 0; jj < nj; ++jj) { const int s = jj * 64 + lane; const int sr = s < n ? s : t;
            const u32x4* kp = (const u32x4*)(WSP(h16s, WS_KIDX) + ((size_t)b * SEQ + sr) * 64); u32x4 kr[8];
#pragma unroll
            for (int i = 0; i < 8; ++i) kr[i] = kp[i];
            float score = 0.f;
#pragma unroll
            for (int hh = 0; hh < 8; ++hh) { float d = 0.f;
#pragma unroll
                for (int i = 0; i < 8; ++i) { const u32x4 qv = qs[hh * 8 + i];
                    const f32x2 k0 = unpkh(kr[i].x), k1 = unpkh(kr[i].y), k2 = unpkh(kr[i].z), k3 = unpkh(kr[i].w), q0 = unpkh(qv.x), q1 = unpkh(qv.y), q2 = unpkh(qv.z), q3 = unpkh(qv.w);
                    d += k0[0] * q0[0]; d += k0[1] * q0[1]; d += k1[0] * q1[0]; d += k1[1] * q1[1]; d += k2[0] * q2[0]; d += k2[1] * q2[1]; d += k3[0] * q3[0]; d += k3[1] * q3[1]; }
                score += wq[hh] * fmaxf(d, 0.f); }
            sc[s] = score; }
        LDS_WAIT(); asm volatile("" ::: "memory");
        unsigned key[32];
#pragma unroll
        for (int jj = 0; jj < 32; ++jj) { const int s = jj * 64 + lane; key[jj] = (s < n) ? sortable(sc[s]) : 0u; }
        unsigned prefix = 0u;
        for (int bit = 31; bit >= 0; --bit) { const unsigned cand = prefix | (1u << bit); int cnt = 0;
#pragma unroll
            for (int jj = 0; jj < 32; ++jj) cnt += __builtin_popcountll(__ballot(key[jj] >= cand));
            if (cnt >= 256) prefix = cand; }
        int ngt = 0;
#pragma unroll
        for (int jj = 0; jj < 32; ++jj) ngt += __builtin_popcountll(__ballot(key[jj] > prefix));
        int need = 256 - ngt, base = 0; const unsigned long long lt = (1ull << lane) - 1ull;
#pragma unroll
        for (int jj = 0; jj < 32; ++jj) { const bool gt = key[jj] > prefix; const bool eq = key[jj] == prefix;
            const unsigned long long meq = __ballot(eq); const int eqrank = __builtin_popcountll(meq & lt); const bool take = gt || (eq && eqrank < need);
            const unsigned long long mt = __ballot(take); if (take) sel[base + __builtin_popcountll(mt & lt)] = jj * 64 + lane;
            base += __builtin_popcountll(mt); const int ne = __builtin_popcountll(meq); need -= (ne < need ? ne : need); }
        LDS_WAIT(); asm volatile("" ::: "memory");
    }
}
__device__ __forceinline__ void p8_attn_naive(Ctx& C) {
    const int tid = C.tid;
    LAS float* qf = (LAS float*)C.lds;
    LAS float* ql = qf + 1024;
    LAS float* sp = ql + 4096;
    LAS float* ol = sp + 4096;
    LAS int* sl = (LAS int*)(ol + 4096);
    const float* wuk = C.in[6]; const float* wuv = C.in[7];
    for (int m = C.bid; m < T; m += C.G) {
        const int t = m & (SEQ - 1), b = m >> 11, cnt = t + 1 < 256 ? t + 1 : 256;
        { const unsigned w = *(const unsigned*)(WSP(h16s, WS_QI) + (size_t)m * 1536 + tid * 2); const f32x2 f = unpkh(w); qf[tid * 2] = f[0]; qf[tid * 2 + 1] = f[1]; }
        if (tid < 256) sl[tid] = WSP(int, WS_SEL)[(size_t)m * 256 + tid];
        __syncthreads();
        { const int h = tid >> 5, r0 = (tid & 31) * 8; f32x4 a0 = (f32x4){0.f, 0.f, 0.f, 0.f}, a1 = a0;
          for (int d = 0; d < 64; ++d) { const float qv = qf[h * 64 + d]; const float* wp = wuk + ((size_t)(h * 64 + d)) * 256 + r0; a0 += qv * *(const f32x4*)wp; a1 += qv * *(const f32x4*)(wp + 4); }
          *(LAS f32x4*)(ql + h * 256 + r0) = a0; *(LAS f32x4*)(ql + h * 256 + r0 + 4) = a1; }
        __syncthreads();
        { const int k = tid & 255, hg = tid >> 8; float acc[8];
#pragma unroll
          for (int i = 0; i < 8; ++i) acc[i] = 0.f;
          if (k < cnt) { const u32x4* kv = (const u32x4*)(WSP(h16s, WS_PQ) + ((size_t)b * SEQ + sl[k]) * 512 + 256);
            for (int rc = 0; rc < 32; ++rc) { const u32x4 w = kv[rc]; const f32x2 x0 = unpkh(w.x), x1 = unpkh(w.y), x2 = unpkh(w.z), x3 = unpkh(w.w);
#pragma unroll
                for (int i = 0; i < 8; ++i) { const LAS float* qp = ql + (hg * 8 + i) * 256 + rc * 8; const f32x4 q0 = *(const LAS f32x4*)qp, q1 = *(const LAS f32x4*)(qp + 4);
                    acc[i] += (x0[0] * q0.x + x0[1] * q0.y) + (x1[0] * q0.z + x1[1] * q0.w) + (x2[0] * q1.x + x2[1] * q1.y) + (x3[0] * q1.z + x3[1] * q1.w); } } }
#pragma unroll
          for (int i = 0; i < 8; ++i) sp[(hg * 8 + i) * 256 + k] = (k < cnt) ? acc[i] * 0.125f : -INFINITY; }
        __syncthreads();
        { const int lane = C.lane;
#pragma unroll
          for (int hh = 0; hh < 2; ++hh) { LAS float* row = sp + (C.wave * 2 + hh) * 256; float v[4]; float mx = -INFINITY;
#pragma unroll
            for (int i = 0; i < 4; ++i) { v[i] = row[i * 64 + lane]; mx = fmaxf(mx, v[i]); }
#pragma unroll
            for (int o = 1; o < 64; o <<= 1) mx = fmaxf(mx, __shfl_xor(mx, o));
            float sum = 0.f;
#pragma unroll
            for (int i = 0; i < 4; ++i) { v[i] = expf(v[i] - mx); sum += v[i]; }
            sum = wave_sum(sum); const float inv = 1.f / sum;
#pragma unroll
            for (int i = 0; i < 4; ++i) row[i * 64 + lane] = v[i] * inv; } }
        __syncthreads();
        { const int r = tid & 255, hg = tid >> 8; float acc[8];
#pragma unroll
          for (int i = 0; i < 8; ++i) acc[i] = 0.f;
          const h16s* kvb = WSP(h16s, WS_PQ) + (size_t)b * SEQ * 512 + 256 + r;
          for (int k = 0; k < cnt; ++k) { const float x = h2f(kvb[(size_t)sl[k] * 512]);
#pragma unroll
              for (int i = 0; i < 8; ++i) acc[i] += sp[(hg * 8 + i) * 256 + k] * x; }
#pragma unroll
          for (int i = 0; i < 8; ++i) ol[(hg * 8 + i) * 256 + r] = acc[i]; }
        __syncthreads();
        { const int h = tid >> 5, d0 = (tid & 31) * 2; float a0 = 0.f, a1 = 0.f;
          for (int r = 0; r < 256; ++r) { const float x = ol[h * 256 + r]; const f32x2 w = *(const f32x2*)(wuv + ((size_t)(h * 256 + r)) * 64 + d0); a0 += x * w.x; a1 += x * w.y; }
          *(unsigned*)(WSP(h16s, WS_OA) + (size_t)m * 1024 + h * 64 + d0) = pkh(a0, a1); }
        __syncthreads();
    }
}


constexpr int SCS = 2064;
__device__ __forceinline__ void p7_topk_mfma(Ctx& C) {
    const int wave = C.wave;
    LAS float* SC = (LAS float*)C.lds;
    const h16s* QI = WSP(h16s, WS_QI); const h16s* KIDX = WSP(h16s, WS_KIDX); const float* WIDX = WSP(float, WS_WIDX);
    for (int it = 0;; ++it) {
        int gi;
        if (C.G == 256) { if (it >= 4) break; const int j = C.bid >> 3; const int gq = (it == 0) ? j : (it == 1) ? 63 - j : (it == 2) ? 64 + j : 127 - j; gi = (C.bid & 7) * 128 + gq; }
        else { gi = C.bid + it * C.G; if (gi >= T / 16) break; }
        const int m0 = gi * 16, b = m0 >> 11, t0 = m0 & (SEQ - 1);
        const int lane = lane_id_asm(), l15 = lane & 15, g = lane >> 4;
        if (t0 + 16 > 256) {
            h16x8 qa[8][2];
#pragma unroll
            for (int hh = 0; hh < 8; ++hh)
#pragma unroll
                for (int ks = 0; ks < 2; ++ks) qa[hh][ks] = *(const h16x8*)(QI + (size_t)(m0 + l15) * 1536 + 1024 + hh * 64 + 32 * ks + 8 * g);
            float wq[4][8];
#pragma unroll
            for (int r = 0; r < 4; ++r)
#pragma unroll
                for (int hh = 0; hh < 8; ++hh) wq[r][hh] = WIDX[(size_t)(m0 + 4 * g + r) * 8 + hh];
            const int nkt = (t0 + 16) >> 4;
#pragma unroll 1
            for (int kt = wave; kt < nkt; kt += NWAVES) {
                const h16s* kp = KIDX + ((size_t)b * SEQ + kt * 16 + l15) * 64 + 8 * g;
                const h16x8 kb0 = *(const h16x8*)kp, kb1 = *(const h16x8*)(kp + 32);
                float sc4[4] = {0.f, 0.f, 0.f, 0.f};
#pragma unroll
                for (int hh = 0; hh < 8; ++hh) { f32x4 acc = (f32x4){0.f, 0.f, 0.f, 0.f};
                    acc = MFMA16(qa[hh][0], kb0, acc); acc = MFMA16(qa[hh][1], kb1, acc);
#pragma unroll
                    for (int r = 0; r < 4; ++r) sc4[r] += wq[r][hh] * fmaxf(acc[r], 0.f); }
#pragma unroll
                for (int r = 0; r < 4; ++r) SC[(4 * g + r) * SCS + kt * 16 + l15] = sc4[r];
            }
        }
        LDS_WAIT(); __syncthreads();
#pragma unroll 1
        for (int qq = 0; qq < 2; ++qq) {
            const int ql = 2 * wave + qq, m = m0 + ql, t = t0 + ql, n = t + 1; int* sel = WSP(int, WS_SEL) + (size_t)m * 256;
            if (n <= 256) { for (int i = lane; i < 256; i += 64) sel[i] = i < n ? i : 0; continue; }
            const LAS float* sc = SC + ql * SCS;
            unsigned key[32];
#pragma unroll
            for (int jj = 0; jj < 32; ++jj) { const int s = jj * 64 + lane; key[jj] = (s < n) ? sortable(sc[s]) : 0u; }
            unsigned prefix = 0u;
            for (int bit = 31; bit >= 0; --bit) { const unsigned cand = prefix | (1u << bit); int cnt = 0;
#pragma unroll
                for (int jj = 0; jj < 32; ++jj) cnt += __builtin_popcountll(__ballot(key[jj] >= cand));
                if (cnt >= 256) prefix = cand; }
            int ngt = 0;
#pragma unroll
            for (int jj = 0; jj < 32; ++jj) ngt += __builtin_popcountll(__ballot(key[jj] > prefix));
            int need = 256 - ngt, base = 0; const unsigned long long lt = (1ull << lane) - 1ull;
#pragma unroll
            for (int jj = 0; jj < 32; ++jj) { const bool gt = key[jj] > prefix; const bool eq = key[jj] == prefix;
                const unsigned long long meq = __ballot(eq); const int eqrank = __builtin_popcountll(meq & lt); const bool take = gt || (eq && eqrank < need);
                const unsigned long long mt = __ballot(take); if (take) sel[base + __builtin_popcountll(mt & lt)] = jj * 64 + lane;
                base += __builtin_popcountll(mt); const int ne = __builtin_popcountll(meq); need -= (ne < need ? ne : need); }
        }
        LDS_WAIT(); __syncthreads();
    }
}

typedef short v4i16_t __attribute__((ext_vector_type(4)));
__device__ __forceinline__ h16x4 tr_read(LAS unsigned char* p) { return __builtin_bit_cast(h16x4, __builtin_amdgcn_ds_read_tr16_b64_v4i16((LAS v4i16_t*)p)); }
__device__ __forceinline__ void p8_attn_mfma(Ctx& C) {
    const int wave = C.wave;
    LAS unsigned char* QL = C.lds;
    LAS unsigned char* KVS = C.lds + wave * 17408;
    const h16s* QI = WSP(h16s, WS_QI); const h16s* PQ = WSP(h16s, WS_PQ); const int* SEL = WSP(int, WS_SEL);
    const h16s* WUKT = WSP(h16s, WS_WUKT); const h16s* WUVT = WSP(h16s, WS_WUVT); h16s* OA = WSP(h16s, WS_OA);
    const float SC = 0.125f * 1.4426950408889634f;
    const int ngrp = T / 8;
    for (int it = 0;; ++it) {
        int gi;
        if (C.G == 256) { if (it >= 8) break; gi = (C.bid & 7) * 256 + (C.bid >> 3) + 32 * it; } else { gi = C.bid + it * C.G; if (gi >= ngrp) break; }
        const int m0 = gi * 8, b = m0 >> 11;
        const int lane = lane_id_asm(), l15 = lane & 15, g = lane >> 4;
#pragma unroll 1
        for (int hh = 0; hh < 2; ++hh) { const int h = 2 * wave + hh;
            const h16s* qp = QI + (size_t)(m0 + (l15 & 7)) * 1536 + h * 64 + 8 * g;
            const h16x8 qb0 = *(const h16x8*)qp, qb1 = *(const h16x8*)(qp + 32);
            const h16s* wp = WUKT + ((size_t)(h * 256 + l15)) * 64 + 8 * g;
#pragma unroll 2
            for (int rt = 0; rt < 16; ++rt) {
                const h16x8 a0 = *(const h16x8*)(wp + rt * 1024), a1 = *(const h16x8*)(wp + rt * 1024 + 32);
                f32x4 acc = (f32x4){0.f, 0.f, 0.f, 0.f};
                acc = MFMA16(a0, qb0, acc); acc = MFMA16(a1, qb1, acc);
                if (l15 < 8) { const int c16 = 2 * rt + (g >> 1); u32x2 w; w.x = pkh(acc[0], acc[1]); w.y = pkh(acc[2], acc[3]);
                    *(LAS u32x2*)(QL + l15 * 8192 + h * 512 + ((c16 ^ (h & 15)) * 16) + (g & 1) * 8) = w; }
            }
        }
        LDS_WAIT(); __syncthreads();
        h16x8 qB[8];
#pragma unroll
        for (int i = 0; i < 8; ++i) qB[i] = *(const LAS h16x8*)(QL + wave * 8192 + l15 * 512 + (((4 * i + g) ^ l15) * 16));
        LDS_WAIT(); __syncthreads();
        const int m = m0 + wave, t = m & (SEQ - 1), cnt = (t + 1 < 256) ? t + 1 : 256, nsteps = (cnt + 31) >> 5;
        const int* selp = SEL + (size_t)m * 256;
        const unsigned char* kvbase = (const unsigned char*)(PQ + (size_t)b * SEQ * 512 + 256) + g * 16;
        f32x4 O[16];
#pragma unroll
        for (int rt = 0; rt < 16; ++rt) O[rt] = (f32x4){0.f, 0.f, 0.f, 0.f};
        float m2 = -INFINITY, lsum = 0.f;
        h16x8 kv[2][8];
        int ia0, ia1, ib0, ib1;
        { const int k0 = l15, k1 = 16 + l15; ia0 = selp[k0 < cnt ? k0 : 0]; ia1 = selp[k1 < cnt ? k1 : 0]; const int k2 = 32 + l15, k3 = 48 + l15; ib0 = selp[k2 < cnt ? k2 : 0]; ib1 = selp[k3 < cnt ? k3 : 0]; }
#pragma unroll
        for (int i = 0; i < 8; ++i) { kv[0][i] = *(const h16x8*)(kvbase + (size_t)ia0 * 1024 + i * 64); kv[1][i] = *(const h16x8*)(kvbase + (size_t)ia1 * 1024 + i * 64); }
#pragma unroll 1
        for (int st = 0; st < nsteps; ++st) {
            int ic0, ic1; { const int k0 = (st + 2) * 32 + l15, k1 = k0 + 16; ic0 = selp[k0 < cnt ? k0 : 0]; ic1 = selp[k1 < cnt ? k1 : 0]; }
            f32x4 s0 = (f32x4){0.f, 0.f, 0.f, 0.f}, s1 = s0;
#pragma unroll
            for (int i = 0; i < 8; ++i) { s0 = MFMA16(kv[0][i], qB[i], s0); s1 = MFMA16(kv[1][i], qB[i], s1); }
#pragma unroll
            for (int tl = 0; tl < 2; ++tl)
#pragma unroll
                for (int i = 0; i < 8; ++i) *(LAS h16x8*)(KVS + (tl * 16 + l15) * 544 + g * 16 + i * 64) = kv[tl][i];
            if (st + 1 < nsteps) {
#pragma unroll
                for (int i = 0; i < 8; ++i) { kv[0][i] = *(const h16x8*)(kvbase + (size_t)ib0 * 1024 + i * 64); kv[1][i] = *(const h16x8*)(kvbase + (size_t)ib1 * 1024 + i * 64); }
            }
            ib0 = ic0; ib1 = ic1;
            float v0[4], v1[4]; float tm = -INFINITY;
#pragma unroll
            for (int r = 0; r < 4; ++r) { const int k0 = st * 32 + 4 * g + r; v0[r] = (k0 < cnt) ? s0[r] * SC : -INFINITY; v1[r] = (k0 + 16 < cnt) ? s1[r] * SC : -INFINITY; tm = fmaxf(tm, fmaxf(v0[r], v1[r])); }
            tm = fmaxf(tm, __shfl_xor(tm, 16)); tm = fmaxf(tm, __shfl_xor(tm, 32));
            if (__any(tm > m2 + 8.f)) { const float mn = fmaxf(m2, tm); const float f = __builtin_amdgcn_exp2f(m2 - mn); m2 = mn; lsum *= f;
#pragma unroll
                for (int rt = 0; rt < 16; ++rt) O[rt] = O[rt] * f; }
            float p0[4], p1[4];
#pragma unroll
            for (int r = 0; r < 4; ++r) { p0[r] = __builtin_amdgcn_exp2f(v0[r] - m2); p1[r] = __builtin_amdgcn_exp2f(v1[r] - m2); lsum += p0[r] + p1[r]; }
            u32x4 pw; pw.x = pkh(p0[0], p0[1]); pw.y = pkh(p0[2], p0[3]); pw.z = pkh(p1[0], p1[1]); pw.w = pkh(p1[2], p1[3]);
            const h16x8 pf = __builtin_bit_cast(h16x8, pw);
            { LAS unsigned char* trb = KVS + (4 * g + (l15 >> 2)) * 544 + (l15 & 3) * 8;
#pragma unroll
              for (int rt = 0; rt < 16; ++rt) {
                const h16x4 lo = tr_read(trb + rt * 32);
                const h16x4 hi = tr_read(trb + 16 * 544 + rt * 32);
                const h16x8 a = (h16x8){lo[0], lo[1], lo[2], lo[3], hi[0], hi[1], hi[2], hi[3]};
                O[rt] = MFMA16(a, pf, O[rt]);
                if ((rt & 3) == 3) __builtin_amdgcn_sched_barrier(0); } }
        }
        lsum += __shfl_xor(lsum, 16); lsum += __shfl_xor(lsum, 32);
        const float inv = 1.f / lsum;
        LDS_WAIT(); __syncthreads();
#pragma unroll
        for (int rt = 0; rt < 16; ++rt) { const int c16 = 2 * rt + (g >> 1); u32x2 w; w.x = pkh(O[rt][0] * inv, O[rt][1] * inv); w.y = pkh(O[rt][2] * inv, O[rt][3] * inv);
            *(LAS u32x2*)(QL + wave * 8192 + l15 * 512 + ((c16 ^ ((wave & 3) << 2)) * 16) + (g & 1) * 8) = w; }
        LDS_WAIT(); __syncthreads();
#pragma unroll 1
        for (int hh = 0; hh < 2; ++hh) { const int h = 2 * wave + hh, tokr = l15 & 7;
#pragma unroll 1
            for (int dt = 0; dt < 4; ++dt) { const h16s* wp = WUVT + ((size_t)(h * 64 + dt * 16 + l15)) * 256 + 8 * g; f32x4 acc = (f32x4){0.f, 0.f, 0.f, 0.f};
#pragma unroll
                for (int ks = 0; ks < 8; ++ks) { const h16x8 a = *(const h16x8*)(wp + ks * 32);
                    const h16x8 bb = *(const LAS h16x8*)(QL + tokr * 8192 + h * 512 + (((4 * ks + g) ^ ((tokr & 3) << 2)) * 16));
                    acc = MFMA16(a, bb, acc); }
                if (l15 < 8) { u32x2 w; w.x = pkh(acc[0], acc[1]); w.y = pkh(acc[2], acc[3]); *(u32x2*)(OA + (size_t)(m0 + l15) * 1024 + h * 64 + dt * 16 + 4 * g) = w; }
            }
        }
        LDS_WAIT(); __syncthreads();
    }
}

__device__ __forceinline__ void p12_hn(Ctx& C) {
    const int gw = C.bid * NWAVES + C.wave, NGW = C.G * NWAVES;
    for (int m = gw; m < T; m += NGW) rms_row_f16(C.out + (size_t)m * DM, C.in[18], WSP(h16s, WS_PZ) + (size_t)m * DM, C.lane);
}
__device__ __forceinline__ void p15_final(Ctx& C) {
    const int gw = C.bid * NWAVES + C.wave, NGW = C.G * NWAVES, lane = C.lane;
    for (int m = gw; m < T; m += NGW) {
        f32x4* xr = (f32x4*)(C.out + (size_t)m * DM) + lane; const f32x4* gr = (const f32x4*)C.in[22] + lane;
        f32x4 v[4]; float s = 0.f;
#pragma unroll
        for (int j = 0; j < 4; ++j) { v[j] = xr[64 * j]; s += (v[j].x * v[j].x + v[j].y * v[j].y) + (v[j].z * v[j].z + v[j].w * v[j].w); }
        const float r = rsqrtf(wave_sum(s) * (1.f / 1024.f) + EPS);
#pragma unroll
        for (int j = 0; j < 4; ++j) { const f32x4 g = gr[64 * j]; xr[64 * j] = (f32x4){v[j].x * r * g.x, v[j].y * r * g.y, v[j].z * r * g.z, v[j].w * r * g.w}; }
    }
}

constexpr int N_PHASES = 16;
struct Args { const float* in[23]; float* out; unsigned char* ws; int ph_lo, ph_hi; };
__global__ void __launch_bounds__(NWAVES * 64, 2) mega_fwd(Args args) {
    extern __shared__ __attribute__((aligned(16))) unsigned char lds[];
    Ctx C;
    C.lds = (LAS unsigned char*)lds;
    C.tid = threadIdx.x; C.lane = C.tid & 63; C.wave = __builtin_amdgcn_readfirstlane(C.tid >> 6);
    C.G = gridDim.x; C.bid = blockIdx.x;
    C.in = args.in;
    C.out = args.out; C.ws = args.ws;
    volatile LAS unsigned* MISC = (volatile LAS unsigned*)(C.lds + MISC_OFF);
    for (int u = C.tid; u < (LDS_BYTES - RING_BYTES) / 4; u += NWAVES * 64) ((LAS unsigned*)(C.lds + RING_BYTES))[u] = 0u;
    __syncthreads();
    const int lo = args.ph_lo, hi = args.ph_hi;
    const bool multi = (hi - lo) > 1;
    XcdBarrier bar; bar.bar = (unsigned*)(C.ws + WS_CTL) + 4096; bar.x = 0; bar.st = nullptr;
    if (multi) bar = xcd_barrier_post((unsigned*)(C.ws + WS_CTL) + 4096, MISC + 8, C.tid == 0);
#define IN(k) (lo <= (k) && (k) < hi && ((C.lane = lane_id_asm()), (C.tid = (C.wave << 6) | C.lane), true))
#define SEAM(k) do { if (lo <= (k) && (k) + 1 < hi) xcd_barrier(bar, C.wave == 0 && lane_id_asm() == 0); } while (0)
    typedef pg8::StaticOrder SO;
    if (IN(0)) { p0_prologue(C); } SEAM(0);
    if (IN(1)) { pg8::Gemm g{DOP(h16s, DO_H), DOP(h16s, DO_WIN), T, INWP, 1024, 1024, 1024}; SO S; S.init(T, INWP, C.G, C.bid);
        pg8::EpiProj E{WSP(h16s, WS_PQ), WSP(h16s, WS_PQKV), WSP(h16s, WS_PZ), WSP(h16s, WS_PG), WSP(float, WS_PS32)};
        pg8::gemm_phase<pg8::EpiProj, SO, true, true>(C.lds, g, S, E, C.tid); } SEAM(1);
    if (IN(2)) { p2_prep(C); } SEAM(2);
#ifdef NAIVE_GDN
    if (IN(3)) { p3_conv_inplace(C); } SEAM(3);
    if (IN(4)) { p4_scan_naive(C); } SEAM(4);
#else
    if (IN(3)) { p3_gdn_prep(C); } SEAM(3);
    if (IN(4)) { p4_gdn_scan(C); } SEAM(4);
#endif
    if (IN(5)) { p5_gated_norm(C); } SEAM(5);
    if (IN(6)) { pg8::Gemm g{WSP(h16s, WS_PQ), WSP(h16s, WS_WQI), T, 1536, 256, 512, 256}; SO S; S.init(T, 1536, C.G, C.bid);
        pg8::EpiF16 E{WSP(h16s, WS_QI), 1536};
        pg8::gemm_phase<pg8::EpiF16, SO, true, true>(C.lds, g, S, E, C.tid); } SEAM(6);
#ifdef NAIVE_TOPK
    if (IN(7)) { p7_topk_naive(C); } SEAM(7);
#else
    if (IN(7)) { p7_topk_mfma(C); } SEAM(7);
#endif
#ifdef NAIVE_ATTN
    if (IN(8)) { p8_attn_naive(C); } SEAM(8);
#else
    if (IN(8)) { p8_attn_mfma(C); } SEAM(8);
#endif
    if (IN(9)) { pg8::Gemm g{WSP(h16s, WS_OA), WSP(h16s, WS_WPA), T, 1024, 1024, 1024, 1024}; SO S; S.init(T, 1024, C.G, C.bid);
        pg8::EpiGateA E{WSP(h16s, WS_PG)};
        pg8::gemm_phase<pg8::EpiGateA, SO, true, true>(C.lds, g, S, E, C.tid); } SEAM(9);
    if (IN(10)) { pg8::Gemm g{WSP(h16s, WS_PZ), WSP(h16s, WS_WPB), T, 1024, 1024, 1024, 1024}; SO S; S.init(T, 1024, C.G, C.bid);
        pg8::EpiMerge E{WSP(h16s, WS_PG)};
        pg8::gemm_phase<pg8::EpiMerge, SO, true, true>(C.lds, g, S, E, C.tid); } SEAM(10);
    if (IN(11)) { pg8::Gemm g{WSP(h16s, WS_PG) + 1024, WSP(h16s, WS_WOUT), T, 1024, 1024, 2048, 1024}; SO S; S.init(T, 1024, C.G, C.bid);
        pg8::EpiRes E{C.in[0], C.out};
        pg8::gemm_phase<pg8::EpiRes, SO, true, true>(C.lds, g, S, E, C.tid); } SEAM(11);
    if (IN(12)) { p12_hn(C); } SEAM(12);
    if (IN(13)) { pg8::Gemm g{WSP(h16s, WS_PZ), WSP(h16s, WS_WGU), T, 5632, 1024, 1024, 1024}; SO S; S.init(T, 5632, C.G, C.bid);
        pg8::EpiSwiglu E{WSP(h16s, WS_ACT)};
        pg8::gemm_phase<pg8::EpiSwiglu, SO, true, true>(C.lds, g, S, E, C.tid); } SEAM(13);
    if (IN(14)) { pg8::Gemm g{WSP(h16s, WS_ACT), WSP(h16s, WS_WDN), T, 1024, 2816, 2816, 2816}; SO S; S.init(T, 1024, C.G, C.bid);
        pg8::EpiRes E{C.out, C.out};
        pg8::gemm_phase<pg8::EpiRes, SO, true, true>(C.lds, g, S, E, C.tid); } SEAM(14);
    if (IN(15)) { p15_final(C); }
#undef IN
#undef SEAM
}

extern "C" void kernel_launch(void* const* d_in, const int* in_sizes, int n_in, void* d_out, int out_size, void* d_ws, size_t ws_size, hipStream_t stream) {
    static int grid = 0;
    if (grid == 0) {
        if (n_in != 23 || in_sizes[0] != T * DM || out_size != T * DM || ws_size < WS_END) { fprintf(stderr, "kernel_launch: unexpected shapes (n_in %d, in0 %d, out %d, ws %zu)\n", n_in, n_in > 0 ? in_sizes[0] : -1, out_size, ws_size); grid = -1; return; }
        int dev = 0, cus = 0, per_cu = 0;
        if (hipGetDevice(&dev) != hipSuccess || hipDeviceGetAttribute(&cus, hipDeviceAttributeMultiprocessorCount, dev) != hipSuccess) { grid = -1; return; }
        if (hipFuncSetAttribute((const void*)mega_fwd, hipFuncAttributeMaxDynamicSharedMemorySize, LDS_BYTES) != hipSuccess) { fprintf(stderr, "kernel_launch: hipFuncSetAttribute failed\n"); grid = -1; return; }
        if (hipOccupancyMaxActiveBlocksPerMultiprocessor(&per_cu, (const void*)mega_fwd, NWAVES * 64, LDS_BYTES) != hipSuccess || per_cu < 1) { fprintf(stderr, "kernel_launch: occupancy query says %d\n", per_cu); per_cu = 1; }
        (void)hipGetLastError();
        grid = cus;
    }
    if (grid < 0) return;
    (void)hipMemsetAsync((char*)d_ws + WS_CTL, 0, CTL_ZERO_BYTES, stream);
    Args a{};
    for (int i = 0; i < 23; ++i) a.in[i] = (const float*)d_in[i];
    a.out = (float*)d_out; a.ws = (unsigned char*)d_ws;
#ifdef MULTI_LAUNCH
    for (int p = 0; p < N_PHASES; ++p) { a.ph_lo = p; a.ph_hi = p + 1; hipLaunchKernelGGL(mega_fwd, dim3(grid), dim3(NWAVES * 64), LDS_BYTES, stream, a); }
#else
    a.ph_lo = 0; a.ph_hi = N_PHASES; hipLaunchKernelGGL(mega_fwd, dim3(grid), dim3(NWAVES * 64), LDS_BYTES, stream, a);
#endif
}
```
